# Optimizing an MI355X kernel written in HIP

```python
import math
import jax, jax.numpy as jnp
from jax import lax
import numpy as np

D_MODEL = 1024
BATCH = 16
SEQ = 2048
DEPTH = 1

CHUNK = 64
Q_BLOCK = 128
NORM_EPS = 1e-6

DA_HEADS = 4
DA_QK_DIM = 64
DA_V_DIM = 2 * DA_QK_DIM
DA_WIDTH = DA_HEADS * DA_V_DIM
ALIBI_SLOPES = tuple(2.0 ** (-8.0 * (h + 1) / DA_HEADS) for h in range(DA_HEADS))

RET_HEADS = 4
RET_QK_DIM = 64
RET_V_DIM = 128
RET_WIDTH = RET_HEADS * RET_V_DIM
RET_GAMMA = tuple(1.0 - 2.0 ** (-5.0 - h) for h in range(RET_HEADS))

MIX_WIDTH = DA_WIDTH + RET_WIDTH

DA_Q_COLS = DA_HEADS * 2 * DA_QK_DIM
DA_K_COLS = DA_HEADS * 2 * DA_QK_DIM
DA_V_COLS = DA_WIDTH
RET_Q_COLS = RET_HEADS * RET_QK_DIM
RET_K_COLS = RET_HEADS * RET_QK_DIM
RET_V_COLS = RET_WIDTH
RET_G_COLS = RET_WIDTH
IN_SPLITS = tuple(np.cumsum([DA_Q_COLS, DA_K_COLS, DA_V_COLS, RET_Q_COLS, RET_K_COLS, RET_V_COLS]).tolist())
IN_WIDTH = DA_Q_COLS + DA_K_COLS + DA_V_COLS + RET_Q_COLS + RET_K_COLS + RET_V_COLS + RET_G_COLS

D_FF = -(-8 * D_MODEL // (3 * 256)) * 256

kernel_name = "hybrid_diffattn_retention_swiglu_sandwich"


def rmsnorm(x, g):
    x32 = x.astype(jnp.float32)
    y = x32 * lax.rsqrt(jnp.mean(x32 * x32, axis=-1, keepdims=True) + NORM_EPS)
    return (y * g.astype(jnp.float32)).astype(x.dtype)


def lambda_init_for(layer_idx):
    return 0.8 - 0.6 * math.exp(-0.3 * layer_idx)


def diff_attention(q, k, v, lam, subln_g, lambda_init):
    B, S = q.shape[0], q.shape[1]
    scale = DA_QK_DIM ** -0.5
    slopes = jnp.asarray(ALIBI_SLOPES, jnp.float32)
    lam32 = lam.astype(jnp.float32)
    outs = []
    for start in range(0, S, Q_BLOCK):
        end = start + Q_BLOCK
        qb = q[:, start:end]
        kb = k[:, :end]
        vb = v[:, :end]
        s = jnp.einsum('bqhmd,bkhmd->bhmqk', qb, kb).astype(jnp.float32) * scale
        qpos = jnp.arange(start, end)
        kpos = jnp.arange(end)
        dist = jnp.abs(qpos[:, None] - kpos[None, :]).astype(jnp.float32)
        bias = -slopes[:, None, None] * dist
        allowed = (kpos[None, :] // CHUNK) <= (qpos[:, None] // CHUNK)
        s = jnp.where(allowed, s + bias[None, :, None], -jnp.inf)
        p = jax.nn.softmax(s, axis=-1)
        pd = p[:, :, 0] - lam32 * p[:, :, 1]
        outs.append(jnp.einsum('bhqk,bkhd->bqhd', pd.astype(vb.dtype), vb))
    o = jnp.concatenate(outs, axis=1)
    o = rmsnorm(o, subln_g) * jnp.asarray(1.0 - lambda_init, o.dtype)
    return o.reshape(B, S, DA_WIDTH)


def retention(q, k, v, gate, norm_g):
    B, S, H, dk = q.shape
    dv = v.shape[-1]
    nc = S // CHUNK
    k = k * jnp.asarray(dk ** -0.5, k.dtype)
    log_g = jnp.log(jnp.asarray(RET_GAMMA, jnp.float32))
    i = jnp.arange(CHUNK, dtype=jnp.float32)
    intra = jnp.exp(log_g[:, None, None] * jnp.abs(i[:, None] - i[None, :]))
    q_decay = jnp.exp(log_g[:, None] * (i + 1.0))
    k_decay = jnp.exp(log_g[:, None] * (CHUNK - 1.0 - i))
    chunk_decay = jnp.exp(log_g * CHUNK)

    def to_chunks(t):
        return t.reshape(B, nc, CHUNK, H, t.shape[-1]).transpose(1, 0, 3, 2, 4)

    qc, kc, vc = to_chunks(q), to_chunks(k), to_chunks(v)

    def step(state, qkv):
        qi, ki, vi = qkv
        s = jnp.einsum('bhid,bhjd->bhij', qi, ki).astype(jnp.float32) * intra
        inner = jnp.einsum('bhij,bhjv->bhiv', s, vi.astype(jnp.float32))
        cross = jnp.einsum('bhid,bhdv->bhiv', qi.astype(jnp.float32) * q_decay[..., None], state)
        new_state = state * chunk_decay[:, None, None] + jnp.einsum(
            'bhjd,bhjv->bhdv', ki.astype(jnp.float32) * k_decay[..., None], vi.astype(jnp.float32))
        return new_state, inner + cross

    state0 = jnp.zeros((B, H, dk, dv), jnp.float32)
    _, o = lax.scan(step, state0, (qc, kc, vc))
    o = o.transpose(1, 0, 3, 2, 4).reshape(B, S, H, dv).astype(v.dtype)
    o = rmsnorm(o, norm_g)
    o = jax.nn.silu(gate) * o
    return o.reshape(B, S, RET_WIDTH)


def setup_inputs(seed: int = 0) -> dict:
    key = jax.random.key(seed)
    ks = jax.random.split(key, 20)
    f32 = jnp.float32

    def nrm(k, shape, scale):
        return jax.random.normal(k, shape, f32) * scale

    def gain(k, shape):
        return 1.0 + 0.02 * jax.random.normal(k, shape, f32)

    return {
        "x": jax.random.normal(ks[0], (BATCH, SEQ, D_MODEL), f32),
        "pre_mix_g": gain(ks[1], (DEPTH, D_MODEL)),
        "w_in": nrm(ks[2], (DEPTH, D_MODEL, IN_WIDTH), D_MODEL ** -0.5),
        "lambda_q1": nrm(ks[3], (DEPTH, DA_QK_DIM), 0.1),
        "lambda_k1": nrm(ks[4], (DEPTH, DA_QK_DIM), 0.1),
        "lambda_q2": nrm(ks[5], (DEPTH, DA_QK_DIM), 0.1),
        "lambda_k2": nrm(ks[6], (DEPTH, DA_QK_DIM), 0.1),
        "da_subln_g": gain(ks[7], (DEPTH, DA_V_DIM)),
        "ret_norm_g": gain(ks[8], (DEPTH, RET_V_DIM)),
        "w_out": nrm(ks[9], (DEPTH, MIX_WIDTH, D_MODEL), MIX_WIDTH ** -0.5),
        "post_mix_g": gain(ks[10], (DEPTH, D_MODEL)),
        "pre_ffn_g": gain(ks[11], (DEPTH, D_MODEL)),
        "w_gate": nrm(ks[12], (DEPTH, D_MODEL, D_FF), D_MODEL ** -0.5),
        "w_up": nrm(ks[13], (DEPTH, D_MODEL, D_FF), D_MODEL ** -0.5),
        "w_down": nrm(ks[14], (DEPTH, D_FF, D_MODEL), D_FF ** -0.5),
        "post_ffn_g": gain(ks[15], (DEPTH, D_MODEL)),
    }


def reference(x, pre_mix_g, w_in, lambda_q1, lambda_k1, lambda_q2, lambda_k2, da_subln_g,
              ret_norm_g, w_out, post_mix_g, pre_ffn_g, w_gate, w_up, w_down, post_ffn_g):
    B, S = x.shape[0], x.shape[1]
    for l in range(DEPTH):
        h = rmsnorm(x, pre_mix_g[l])
        proj = jnp.einsum('bsd,de->bse', h, w_in[l])
        da_q, da_k, da_v, r_q, r_k, r_v, r_g = jnp.split(proj, IN_SPLITS, axis=-1)
        da_q = da_q.reshape(B, S, DA_HEADS, 2, DA_QK_DIM)
        da_k = da_k.reshape(B, S, DA_HEADS, 2, DA_QK_DIM)
        da_v = da_v.reshape(B, S, DA_HEADS, DA_V_DIM)
        lam_init = lambda_init_for(l)
        lam = (jnp.exp(jnp.sum(lambda_q1[l].astype(jnp.float32) * lambda_k1[l].astype(jnp.float32)))
               - jnp.exp(jnp.sum(lambda_q2[l].astype(jnp.float32) * lambda_k2[l].astype(jnp.float32)))
               + lam_init)
        o_da = diff_attention(da_q, da_k, da_v, lam, da_subln_g[l], lam_init)
        o_ret = retention(r_q.reshape(B, S, RET_HEADS, RET_QK_DIM),
                          r_k.reshape(B, S, RET_HEADS, RET_QK_DIM),
                          r_v.reshape(B, S, RET_HEADS, RET_V_DIM),
                          r_g.reshape(B, S, RET_HEADS, RET_V_DIM),
                          ret_norm_g[l])
        mix = jnp.einsum('bse,ed->bsd', jnp.concatenate([o_da, o_ret], axis=-1), w_out[l])
        x = x + rmsnorm(mix, post_mix_g[l])
        h = rmsnorm(x, pre_ffn_g[l])
        f = jax.nn.silu(jnp.einsum('bsd,df->bsf', h, w_gate[l])) * jnp.einsum('bsd,df->bsf', h, w_up[l])
        f = jnp.einsum('bsf,fd->bsd', f, w_down[l])
        x = x + rmsnorm(f, post_ffn_g[l])
    return x
```

```cpp
#include <hip/hip_runtime.h>
#include <hip/hip_cooperative_groups.h>
#include <cstdio>
namespace cg = cooperative_groups;

#define LAS __attribute__((address_space(3)))
typedef unsigned short bf16_t;
typedef short bf16x8 __attribute__((ext_vector_type(8)));
typedef float f32x4 __attribute__((ext_vector_type(4)));
typedef float f32x16 __attribute__((ext_vector_type(16)));
typedef unsigned u32x4 __attribute__((ext_vector_type(4)));
typedef unsigned u32x2 __attribute__((ext_vector_type(2)));

constexpr int MTOK = 32768, DM = 1024, SEQ = 2048, DFF = 2816;
constexpr float EPS = 1e-6f;
constexpr float LOG2E = 1.4426950408889634f;

constexpr size_t MiB = 1024 * 1024;
constexpr size_t WS_WA = 0;
constexpr size_t WS_WV = WS_WA + 4 * MiB;
constexpr size_t WS_WO = WS_WV + 2 * MiB;
constexpr size_t WS_WGU = WS_WO + 2 * MiB;
constexpr size_t WS_WD = WS_WGU + 11 * MiB;
constexpr size_t WS_H = WS_WD + 6 * MiB;
constexpr size_t WS_QK = WS_H + 64 * MiB;
constexpr size_t WS_VT = WS_QK + 128 * MiB;
constexpr int VT_ROWS = 1040;
constexpr size_t WS_OMIX = WS_VT + 72 * MiB;
constexpr size_t WS_MIXB = WS_OMIX + 64 * MiB;
constexpr size_t WS_F = WS_QK;
constexpr size_t WS_K2 = WS_MIXB + 64 * MiB;
constexpr size_t WS_BAR = WS_K2 + 48 * MiB;
constexpr size_t WS_STAT = WS_BAR + 32768;
constexpr size_t STAT_SS_BYTES = (size_t)MTOK * 8, STAT_CNT_OFF = 3 * STAT_SS_BYTES, STAT_BYTES = STAT_CNT_OFF + 3 * 256 * 256;
constexpr size_t WS_END = WS_STAT + STAT_BYTES;

struct Args {
    const float* x; const float* pre_mix_g; const float* w_in; const float* lq1; const float* lk1; const float* lq2; const float* lk2;
    const float* subln_g; const float* ret_g; const float* w_out; const float* post_mix_g; const float* pre_ffn_g;
    const float* w_gate; const float* w_up; const float* w_down; const float* post_ffn_g;
    float* out; unsigned char* ws;
};

__device__ __forceinline__ unsigned cvt_pk_bf16(float lo, float hi) { unsigned r; asm("v_cvt_pk_bf16_f32 %0, %1, %2" : "=v"(r) : "v"(lo), "v"(hi)); return r; }
__device__ __forceinline__ float bf_lo(unsigned w) { return __uint_as_float(w << 16); }
__device__ __forceinline__ float bf_hi(unsigned w) { return __uint_as_float(w & 0xffff0000u); }
__device__ __forceinline__ float a_add(float a, float b)  { float r; asm("v_add_f32_e32 %0, %1, %2" : "=v"(r) : "v"(a), "v"(b)); return r; }
__device__ __forceinline__ float a_adds(float s_, float b) { float r; asm("v_add_f32_e32 %0, %1, %2" : "=v"(r) : "s"(s_), "v"(b)); return r; }
__device__ __forceinline__ float a_mul(float a, float b)  { float r; asm("v_mul_f32_e32 %0, %1, %2" : "=v"(r) : "v"(a), "v"(b)); return r; }
__device__ __forceinline__ float a_muls(float s_, float b) { float r; asm("v_mul_f32_e32 %0, %1, %2" : "=v"(r) : "s"(s_), "v"(b)); return r; }
__device__ __forceinline__ float a_max(float a, float b)  { float r; asm("v_max_f32_e32 %0, %1, %2" : "=v"(r) : "v"(a), "v"(b)); return r; }
__device__ __forceinline__ float a_max3(float a, float b, float c) { float r; asm("v_max3_f32 %0, %1, %2, %3" : "=v"(r) : "v"(a), "v"(b), "v"(c)); return r; }
#define MFMA_GUARD(X, Y) asm volatile("s_nop 15\n\ts_nop 3" : "+v"(X), "+v"(Y))
__device__ __forceinline__ float half_sum(float v) { auto rr = __builtin_amdgcn_permlane32_swap(__float_as_uint(v), __float_as_uint(v), false, false); return __uint_as_float(rr[0]) + __uint_as_float(rr[1]); }
__device__ __forceinline__ float half_max(float v) { auto rr = __builtin_amdgcn_permlane32_swap(__float_as_uint(v), __float_as_uint(v), false, false); return fmaxf(__uint_as_float(rr[0]), __uint_as_float(rr[1])); }
__device__ __forceinline__ float wave_sum(float v) {
#pragma unroll
    for (int o = 32; o > 0; o >>= 1) v += __shfl_xor(v, o);
    return v;
}

#define XB_TMO      128
#define XB_XCNT(j)  (256  + 64 * (j))
#define XB_XSUB(j)  (1280 + 64 * (j))
#define XB_XGEN(j)  (2304 + 64 * (j))
#define XB_TOP      3328
#define XB_TOPGEN   3392
#define XCD_BAR_WORDS 3456
#define XB_TKT(j)   (3456 + 64 * (j))
#define XB_ALL_WORDS (3456 + 16 * 64)
#define XB_SPIN_CAP (1u << 18)
__device__ __forceinline__ unsigned xb_ld(unsigned* p)              { return __hip_atomic_load(p, __ATOMIC_RELAXED, __HIP_MEMORY_SCOPE_AGENT); }
__device__ __forceinline__ unsigned xb_add(unsigned* p, unsigned v) { return __hip_atomic_fetch_add(p, v, __ATOMIC_RELAXED, __HIP_MEMORY_SCOPE_AGENT); }
__device__ __forceinline__ unsigned xb_xcc_id() { return (unsigned)__builtin_amdgcn_s_getreg((3 << 11) | 20) & 0xFu; }
#define XB_SPIN(cond, bar) do { unsigned _sp = 0; while (cond) { __builtin_amdgcn_s_sleep(1); \
    if ((++_sp & 255u) == 0u) { if (xb_ld(&(bar)[XB_TMO])) break; if (_sp > XB_SPIN_CAP) { atomicAdd(&(bar)[XB_TMO], 1u); break; } } } } while (0)
struct XcdBarrier { unsigned* bar; unsigned x; volatile LAS unsigned* st; };
__device__ __forceinline__ XcdBarrier xcd_barrier_post(unsigned* bar, volatile LAS unsigned* st) {
    XcdBarrier b; b.bar = bar; b.x = xb_xcc_id(); b.st = st;
    if (threadIdx.x == 0) (void)xb_add(&bar[XB_XCNT(b.x)], 1u);
    return b;
}
__device__ __forceinline__ void xcd_barrier_complete(unsigned* bar, unsigned x, unsigned& nloc, unsigned& nx) {
    const unsigned G = gridDim.x * gridDim.y * gridDim.z;
    unsigned sum, cnt, mine, sp = 0u;
    for (;;) {
        sum = 0u; cnt = 0u; mine = 0u;
#pragma unroll
        for (unsigned j = 0; j < 16; ++j) { const unsigned c = xb_ld(&bar[XB_XCNT(j)]); sum += c; cnt += (c > 0u) ? 1u : 0u; mine = (j == x) ? c : mine; }
        if (sum == G) break;
        __builtin_amdgcn_s_sleep(1);
        if ((++sp & 255u) == 0u) { if (xb_ld(&bar[XB_TMO])) break; if (sp > XB_SPIN_CAP) { atomicAdd(&bar[XB_TMO], 1u); break; } }
    }
    nloc = mine > 0u ? mine : 1u; nx = cnt > 0u ? cnt : 1u;
}
__device__ __forceinline__ void xcd_barrier(const XcdBarrier& b) {
    asm volatile("s_waitcnt vmcnt(0)" ::: "memory");
    __syncthreads();
    if (threadIdx.x == 0) {
        unsigned* bar = b.bar;
        __builtin_amdgcn_s_waitcnt(0);
        unsigned nloc = b.st[0], nx = b.st[1];
        if (nloc == 0u) { xcd_barrier_complete(bar, b.x, nloc, nx); b.st[0] = nloc; b.st[1] = nx; }
        const unsigned old = xb_add(&bar[XB_XSUB(b.x)], 1u);
        const unsigned gen = old / nloc;
        if (old + 1u == (gen + 1u) * nloc) {
            __builtin_amdgcn_fence(__ATOMIC_RELEASE, "agent");
            asm volatile("s_waitcnt vmcnt(0)" ::: "memory");
            const unsigned og = xb_add(&bar[XB_TOP], 1u);
            const unsigned tg = og / nx;
            if (og + 1u == (tg + 1u) * nx) xb_add(&bar[XB_TOPGEN], 1u);
            else XB_SPIN(xb_ld(&bar[XB_TOPGEN]) == tg, bar);
            __builtin_amdgcn_fence(__ATOMIC_ACQUIRE, "agent");
            xb_add(&bar[XB_XGEN(b.x)], 1u);
            asm volatile("s_waitcnt vmcnt(0)" ::: "memory");
        } else {
            XB_SPIN(xb_ld(&bar[XB_XGEN(b.x)]) == gen, bar);
            __builtin_amdgcn_fence(__ATOMIC_ACQUIRE, "agent");
            asm volatile("s_waitcnt vmcnt(0)" ::: "memory");
        }
    }
    __syncthreads();
}

namespace pg8 {
constexpr int BM = 256, BK = 64, HALF = 128, HTB = HALF * BK * 2, STAGE_BYTES = 8 * HTB, NXCD = 8, WGM = 8;
__host__ __device__ __forceinline__ int lds_byte(int r, int c) { const int st = (r >> 4) * 2 + (c >> 5), rr = r & 15, cc = c & 31, ob = rr * 64 + cc * 2; return st * 1024 + (ob ^ (((ob >> 9) & 1) << 5)); }
__host__ __device__ __forceinline__ void stage_rc(int b, int& R, int& C) { const int st = b / 1024, sb = b % 1024, swz = sb ^ (((sb >> 9) & 1) << 5); R = (st >> 1) * 16 + swz / 64; C = (st & 1) * 32 + (swz % 64) / 2; }
__host__ __device__ __forceinline__ int perm32(int rho) { const int n = rho >> 4, i = rho & 15; return 8 * (i >> 2) + 4 * n + (i & 3); }
struct Unit { int pm, pn; };
struct Gemm { const bf16_t* A; const bf16_t* Bt; int M, N, K; };
struct StaticOrder {
    int nM, nN, nwg, G, c;
    __host__ __device__ void init(int M, int N, int G_, int c_) { nM = M / BM; nN = N / BM; nwg = nM * nN; G = G_; c = c_; }
    __host__ __device__ bool next(int i, Unit& u) const {
        const long L = (long)i * G + c; if (L >= nwg) return false;
        int wgid = (int)L; { const int q = nwg / NXCD, r = nwg % NXCD, xcd = wgid % NXCD, off = wgid / NXCD; wgid = (xcd < r ? xcd * (q + 1) : r * (q + 1) + (xcd - r) * q) + off; }
        const int nig = WGM * nN, gid = wgid / nig, fm = gid * WGM, gsz = (nM - fm) < WGM ? (nM - fm) : WGM;
        u.pm = fm + ((wgid % nig) % gsz); u.pn = (wgid % nig) / gsz; return true;
    }
};

struct EpiBf16 {
    bf16_t* O; int ldc;
    __device__ __forceinline__ void operator()(const f32x4 (&acc)[2][2][4][2], const Unit& u, int wr, int wc, int fr, int fq) const {
        const int row0 = u.pm * BM + wr * 64 + fr; const int col0 = u.pn * BM + wc * 32 + 8 * fq;
#pragma unroll
        for (int ai = 0; ai < 2; ++ai)
#pragma unroll
            for (int m = 0; m < 4; ++m) { bf16_t* rowp = O + (size_t)(row0 + ai * HALF + m * 16) * ldc + col0;
#pragma unroll
                for (int bj = 0; bj < 2; ++bj) { const f32x4 v0 = acc[ai][bj][m][0], v1 = acc[ai][bj][m][1];
                    u32x4 w; w.x = cvt_pk_bf16(v0[0], v0[1]); w.y = cvt_pk_bf16(v0[2], v0[3]); w.z = cvt_pk_bf16(v1[0], v1[1]); w.w = cvt_pk_bf16(v1[2], v1[3]);
                    *(u32x4*)(rowp + bj * HALF) = w; } }
    }
};
struct EpiQK {
    bf16_t* O; bf16_t* K2;
    __device__ __forceinline__ void operator()(const f32x4 (&acc)[2][2][4][2], const Unit& u, int wr, int wc, int fr, int fq) const {
        const int row0 = u.pm * BM + wr * 64 + fr;
        const bool isk = (u.pn == 2) || (u.pn == 3) || (u.pn == 5);
        const int slot0 = u.pn == 5 ? 4 : (u.pn - 2) * 2;
#pragma unroll
        for (int ai = 0; ai < 2; ++ai)
#pragma unroll
            for (int m = 0; m < 4; ++m) { const int row = row0 + ai * HALF + m * 16;
#pragma unroll
                for (int bj = 0; bj < 2; ++bj) { const f32x4 v0 = acc[ai][bj][m][0], v1 = acc[ai][bj][m][1];
                    u32x4 w; w.x = cvt_pk_bf16(v0[0], v0[1]); w.y = cvt_pk_bf16(v0[2], v0[3]); w.z = cvt_pk_bf16(v1[0], v1[1]); w.w = cvt_pk_bf16(v1[2], v1[3]);
                    bf16_t* p = isk ? K2 + ((size_t)((row >> 6) * 6 + slot0 + bj) * 64 + (row & 63)) * 128 + wc * 32 + 8 * fq
                                    : O + (size_t)row * 2048 + u.pn * BM + bj * HALF + wc * 32 + 8 * fq;
                    *(u32x4*)p = w; } }
    }
};
struct EpiVT {
    bf16_t* V2;
    __device__ __forceinline__ void operator()(const f32x4 (&acc)[2][2][4][2], const Unit& u, int wr, int wc, int fr, int fq) const {
        const int row0 = u.pm * BM + wr * 64 + fr;
#pragma unroll
        for (int ai = 0; ai < 2; ++ai)
#pragma unroll
            for (int m = 0; m < 4; ++m) { const int row = row0 + ai * HALF + m * 16;
#pragma unroll
                for (int bj = 0; bj < 2; ++bj) { const f32x4 v0 = acc[ai][bj][m][0], v1 = acc[ai][bj][m][1];
                    u32x4 w; w.x = cvt_pk_bf16(v0[0], v0[1]); w.y = cvt_pk_bf16(v0[2], v0[3]); w.z = cvt_pk_bf16(v1[0], v1[1]); w.w = cvt_pk_bf16(v1[2], v1[3]);
                    const int T = u.pn * 4 + bj * 2 + (wc >> 1);
                    *(u32x4*)(V2 + ((size_t)T * VT_ROWS + row) * 64 + (wc & 1) * 32 + 8 * fq) = w; } }
    }
};
constexpr float SS_SCALE = 16777216.0f, SS_INV = 1.0f / 16777216.0f;
__device__ __forceinline__ void row_ss_publish(const float (&ps)[2][4], unsigned long long* rowss, unsigned* cnt, int row0, int fq, int lane) {
    if (fq == 0) {
#pragma unroll
        for (int ai = 0; ai < 2; ++ai)
#pragma unroll
            for (int m = 0; m < 4; ++m) (void)__hip_atomic_fetch_add(rowss + row0 + ai * HALF + m * 16, (unsigned long long)(ps[ai][m] * SS_SCALE), __ATOMIC_RELAXED, __HIP_MEMORY_SCOPE_AGENT);
    }
    asm volatile("s_waitcnt vmcnt(0)" ::: "memory");
    if (lane == 0) (void)__hip_atomic_fetch_add(cnt, 1u, __ATOMIC_RELAXED, __HIP_MEMORY_SCOPE_AGENT);
    unsigned spins = 0;
    while (__hip_atomic_load(cnt, __ATOMIC_RELAXED, __HIP_MEMORY_SCOPE_AGENT) < 16u) { __builtin_amdgcn_s_sleep(2); if (++spins > (1u << 22)) break; }
    asm volatile("" ::: "memory");
}
__device__ __forceinline__ void row_rn_fetch(float (&rn)[2][4], unsigned long long* rowss, int row0) {
#pragma unroll
    for (int ai = 0; ai < 2; ++ai)
#pragma unroll
        for (int m = 0; m < 4; ++m) { const unsigned long long t = __hip_atomic_load(rowss + row0 + ai * HALF + m * 16, __ATOMIC_RELAXED, __HIP_MEMORY_SCOPE_AGENT);
            rn[ai][m] = __frsqrt_rn((float)t * SS_INV * (1.0f / 1024.0f) + EPS); }
}
struct EpiNormRes {
    float* out; const bf16_t* X1B; const float* g; unsigned long long* rowss; unsigned* cnt;
    __device__ __forceinline__ void operator()(f32x4 (&acc)[2][2][4][2], const Unit& u, int wr, int wc, int fr, int fq) const {
        const int row0 = u.pm * BM + wr * 64 + fr, col0 = u.pn * BM + wc * 32 + 8 * fq, lane = fq * 16 + fr;
        float ps[2][4], rn[2][4];
#pragma unroll
        for (int ai = 0; ai < 2; ++ai)
#pragma unroll
            for (int m = 0; m < 4; ++m) { float t = 0.f;
#pragma unroll
                for (int bj = 0; bj < 2; ++bj)
#pragma unroll
                    for (int n = 0; n < 2; ++n)
#pragma unroll
                        for (int e = 0; e < 4; ++e) t += acc[ai][bj][m][n][e] * acc[ai][bj][m][n][e];
                t += __shfl_xor(t, 16); t += __shfl_xor(t, 32); ps[ai][m] = t; }
        u32x4 xpre[2][4][2];
#pragma unroll
        for (int ai = 0; ai < 2; ++ai)
#pragma unroll
            for (int m = 0; m < 4; ++m)
#pragma unroll
                for (int bj = 0; bj < 2; ++bj) xpre[ai][m][bj] = *(const u32x4*)(X1B + (size_t)(row0 + ai * HALF + m * 16) * 1024 + col0 + bj * HALF);
        row_ss_publish(ps, rowss, cnt + (u.pm * 2 + wr) * 64, row0, fq, lane);
        row_rn_fetch(rn, rowss, row0);
#pragma unroll
        for (int ai = 0; ai < 2; ++ai)
#pragma unroll
            for (int m = 0; m < 4; ++m) { float* rowp = out + (size_t)(row0 + ai * HALF + m * 16) * 1024 + col0;
#pragma unroll
                for (int bj = 0; bj < 2; ++bj) { float* p = rowp + bj * HALF; const float* gp = g + col0 + bj * HALF;
                    const f32x4 g0 = *(const f32x4*)gp, g1 = *(const f32x4*)(gp + 4);
                    const u32x4 xw = xpre[ai][m][bj];
                    f32x4 x0 = (f32x4){bf_lo(xw.x), bf_hi(xw.x), bf_lo(xw.y), bf_hi(xw.y)}, x1 = (f32x4){bf_lo(xw.z), bf_hi(xw.z), bf_lo(xw.w), bf_hi(xw.w)};
                    x0 += acc[ai][bj][m][0] * rn[ai][m] * g0; x1 += acc[ai][bj][m][1] * rn[ai][m] * g1;
                    __builtin_nontemporal_store(x0, (f32x4*)p); __builtin_nontemporal_store(x1, (f32x4*)(p + 4)); } }
    }
};
struct EpiNormResNorm {
    const float* x; bf16_t* X1B; const float* g1; unsigned long long* rowss1; unsigned long long* rowss2; unsigned* cnt1;
    __device__ __forceinline__ void operator()(f32x4 (&acc)[2][2][4][2], const Unit& u, int wr, int wc, int fr, int fq) const {
        const int row0 = u.pm * BM + wr * 64 + fr, col0 = u.pn * BM + wc * 32 + 8 * fq, lane = fq * 16 + fr;
        float ps[2][4], rn[2][4];
#pragma unroll
        for (int ai = 0; ai < 2; ++ai)
#pragma unroll
            for (int m = 0; m < 4; ++m) { float t = 0.f;
#pragma unroll
                for (int bj = 0; bj < 2; ++bj)
#pragma unroll
                    for (int n = 0; n < 2; ++n)
#pragma unroll
                        for (int e = 0; e < 4; ++e) t += acc[ai][bj][m][n][e] * acc[ai][bj][m][n][e];
                t += __shfl_xor(t, 16); t += __shfl_xor(t, 32); ps[ai][m] = t; }
        row_ss_publish(ps, rowss1, cnt1 + (u.pm * 2 + wr) * 64, row0, fq, lane);
        row_rn_fetch(rn, rowss1, row0);
#pragma unroll
        for (int ai = 0; ai < 2; ++ai)
#pragma unroll
            for (int m = 0; m < 4; ++m) { const float* xrow = x + (size_t)(row0 + ai * HALF + m * 16) * 1024 + col0; float t = 0.f;
#pragma unroll
                for (int bj = 0; bj < 2; ++bj) { const float* gp = g1 + col0 + bj * HALF;
                    const f32x4 g0 = *(const f32x4*)gp, g1v = *(const f32x4*)(gp + 4);
                    const f32x4 x0 = __builtin_nontemporal_load((const f32x4*)(xrow + bj * HALF)), x1 = __builtin_nontemporal_load((const f32x4*)(xrow + bj * HALF + 4));
                    const f32x4 v0 = x0 + acc[ai][bj][m][0] * rn[ai][m] * g0, v1 = x1 + acc[ai][bj][m][1] * rn[ai][m] * g1v;
                    acc[ai][bj][m][0] = v0; acc[ai][bj][m][1] = v1;
#pragma unroll
                    for (int e = 0; e < 4; ++e) t += v0[e] * v0[e] + v1[e] * v1[e]; }
                t += __shfl_xor(t, 16); t += __shfl_xor(t, 32); ps[ai][m] = t; }
        if (fq == 0) {
#pragma unroll
            for (int ai = 0; ai < 2; ++ai)
#pragma unroll
                for (int m = 0; m < 4; ++m) (void)__hip_atomic_fetch_add(rowss2 + row0 + ai * HALF + m * 16, (unsigned long long)(ps[ai][m] * SS_SCALE), __ATOMIC_RELAXED, __HIP_MEMORY_SCOPE_AGENT);
        }
#pragma unroll
        for (int ai = 0; ai < 2; ++ai)
#pragma unroll
            for (int m = 0; m < 4; ++m) { const size_t ro = (size_t)(row0 + ai * HALF + m * 16) * 1024 + col0;
#pragma unroll
                for (int bj = 0; bj < 2; ++bj) { const f32x4 v0 = acc[ai][bj][m][0], v1 = acc[ai][bj][m][1];
                    u32x4 wx; wx.x = cvt_pk_bf16(v0[0], v0[1]); wx.y = cvt_pk_bf16(v0[2], v0[3]); wx.z = cvt_pk_bf16(v1[0], v1[1]); wx.w = cvt_pk_bf16(v1[2], v1[3]);
                    *(u32x4*)(X1B + ro + bj * HALF) = wx; } }
    }
};
__device__ __forceinline__ float silu_mul(float g, float u) { return g * u * __builtin_amdgcn_rcpf(1.0f + __builtin_amdgcn_exp2f(-g * LOG2E)); }
struct EpiSwiGLU {
    bf16_t* F; int ldf; const unsigned long long* rowss;
    __device__ __forceinline__ void operator()(const f32x4 (&acc)[2][2][4][2], const Unit& u, int wr, int wc, int fr, int fq) const {
        const int row0 = u.pm * BM + wr * 64 + fr; const int col0 = u.pn * HALF + wc * 32 + 8 * fq;
        float rn[2][4];
#pragma unroll
        for (int ai = 0; ai < 2; ++ai)
#pragma unroll
            for (int m = 0; m < 4; ++m) rn[ai][m] = __frsqrt_rn((float)rowss[row0 + ai * HALF + m * 16] * SS_INV * (1.0f / 1024.0f) + EPS);
#pragma unroll
        for (int ai = 0; ai < 2; ++ai)
#pragma unroll
            for (int m = 0; m < 4; ++m) { bf16_t* rowp = F + (size_t)(row0 + ai * HALF + m * 16) * ldf + col0; const float r = rn[ai][m];
                const f32x4 g0 = acc[ai][0][m][0] * r, g1 = acc[ai][0][m][1] * r, u0 = acc[ai][1][m][0] * r, u1 = acc[ai][1][m][1] * r;
                u32x4 w; w.x = cvt_pk_bf16(silu_mul(g0[0], u0[0]), silu_mul(g0[1], u0[1])); w.y = cvt_pk_bf16(silu_mul(g0[2], u0[2]), silu_mul(g0[3], u0[3]));
                w.z = cvt_pk_bf16(silu_mul(g1[0], u1[0]), silu_mul(g1[1], u1[1])); w.w = cvt_pk_bf16(silu_mul(g1[2], u1[2]), silu_mul(g1[3], u1[3]));
                *(u32x4*)rowp = w; }
    }
};

template <class Epi>
__device__ __forceinline__ void gemm_phase(LAS unsigned char* lds, const Gemm g, const StaticOrder& S, const Epi& E) {
    int tid_ = threadIdx.x; asm volatile("" : "+v"(tid_));
    const int tid = tid_, wid = __builtin_amdgcn_readfirstlane(tid >> 6), lane = tid & 63, wr = wid >> 2, wc = wid & 3, fr = lane & 15, fq = lane >> 4;
    const int K = g.K, nt = K / BK;
    unsigned voffA[2], voffB[2];
#pragma unroll
    for (int i = 0; i < 2; ++i) { int R, C; stage_rc(tid * 16 + i * 8192, R, C); const int Rb = (R & ~31) + perm32(R & 31);
        voffA[i] = (unsigned)(R * K + C) * 2u; voffB[i] = (unsigned)(Rb * K + C) * 2u; }
    const size_t kstep = (size_t)(BK * 2);
    const size_t hstep = (size_t)HALF * K * 2;
    const size_t tstep = 2 * hstep;
    const unsigned ldsw = (unsigned)wid * 1024u;
    const int aoff = lds_byte(wr * 64 + fr, fq * 8), boff = lds_byte(wc * 32 + fr, fq * 8);
#define PG8_SA(b, h) (((b) * 2 + (h)) * HTB)
#define PG8_SB(b, h) ((4 + (b) * 2 + (h)) * HTB)
#define PG8_STAGE(bufoff, gbase, voff) do { _Pragma("unroll") for (int _i = 0; _i < 2; ++_i) \
        __builtin_amdgcn_global_load_lds((const unsigned*)((const char*)(gbase) + (voff)[_i]), (LAS unsigned*)(lds + (bufoff) + ldsw + _i * 8192), 16, 0, 0); } while (0)
#define PG8_LDA(dst, b, h) do { _Pragma("unroll") for (int m = 0; m < 4; ++m) _Pragma("unroll") for (int k = 0; k < 2; ++k) dst[m][k] = *(const LAS bf16x8*)(lds + PG8_SA(b, h) + aoff + m * 2048 + k * 1024); } while (0)
#define PG8_LDB(dst, b, h) do { _Pragma("unroll") for (int n = 0; n < 2; ++n) _Pragma("unroll") for (int k = 0; k < 2; ++k) dst[n][k] = *(const LAS bf16x8*)(lds + PG8_SB(b, h) + boff + n * 2048 + k * 1024); } while (0)
#define PG8_MMA(ai, bj, At, Bt) do { __builtin_amdgcn_s_setprio(1); _Pragma("unroll") for (int m = 0; m < 4; ++m) _Pragma("unroll") for (int n = 0; n < 2; ++n) _Pragma("unroll") for (int k = 0; k < 2; ++k) \
        acc[ai][bj][m][n] = __builtin_amdgcn_mfma_f32_16x16x32_bf16(Bt[n][k], At[m][k], acc[ai][bj][m][n], 0, 0, 0); __builtin_amdgcn_s_setprio(0); } while (0)
#define PG8_WAIT_V(n) asm volatile("s_waitcnt vmcnt(" #n ")" ::: "memory")
#define PG8_WAIT_L(n) asm volatile("s_waitcnt lgkmcnt(" #n ")" ::: "memory")
#define PG8_BAR __builtin_amdgcn_s_barrier()
#define PG8_SCHED __builtin_amdgcn_sched_barrier(0)
    Unit cur, nxt; int ui = 0;
    if (!S.next(0, cur)) return;
    f32x4 acc[2][2][4][2];
#pragma unroll
    for (int a = 0; a < 2; ++a)
#pragma unroll
        for (int b = 0; b < 2; ++b)
#pragma unroll
            for (int m = 0; m < 4; ++m)
#pragma unroll
                for (int n = 0; n < 2; ++n) acc[a][b][m][n] = (f32x4){0.f, 0.f, 0.f, 0.f};
    bf16x8 At[4][2], B0[2][2], B1[2][2];
    const char* cA = (const char*)g.A + (size_t)cur.pm * tstep; const char* cB = (const char*)g.Bt + (size_t)cur.pn * tstep;
    PG8_STAGE(PG8_SB(0, 0), cB, voffB); PG8_STAGE(PG8_SA(0, 0), cA, voffA); PG8_STAGE(PG8_SB(0, 1), cB + hstep, voffB); PG8_STAGE(PG8_SA(0, 1), cA + hstep, voffA);
    if (wr == 1) PG8_BAR;
    PG8_WAIT_V(4); PG8_BAR;
    PG8_STAGE(PG8_SB(1, 0), cB + kstep, voffB); PG8_STAGE(PG8_SA(1, 0), cA + kstep, voffA); PG8_STAGE(PG8_SB(1, 1), cB + hstep + kstep, voffB);
    PG8_WAIT_V(6); PG8_BAR;
    for (;;) {
        const bool has_next = S.next(ui + 1, nxt);
        const char* nA = has_next ? (const char*)g.A + (size_t)nxt.pm * tstep : cA; const char* nB = has_next ? (const char*)g.Bt + (size_t)nxt.pn * tstep : cB;
        for (int t = 0; t < nt; t += 2) {
            const bool last = (t == nt - 2);
            const char* a1 = cA + (size_t)(t + 1) * kstep;
            const char* a2 = last ? nA : cA + (size_t)(t + 2) * kstep; const char* b2 = last ? nB : cB + (size_t)(t + 2) * kstep;
            const char* a3 = a2 + kstep; const char* b3 = b2 + kstep;
            PG8_LDB(B0, 0, 0); PG8_SCHED; PG8_LDA(At, 0, 0); PG8_STAGE(PG8_SA(1, 1), a1 + hstep, voffA);
            PG8_WAIT_L(8); PG8_BAR; PG8_WAIT_L(0); PG8_MMA(0, 0, At, B0); PG8_BAR; PG8_SCHED;
            PG8_LDB(B1, 0, 1); PG8_STAGE(PG8_SB(0, 0), b2, voffB);
            PG8_BAR; PG8_WAIT_L(0); PG8_MMA(0, 1, At, B1); PG8_BAR;
            PG8_LDA(At, 0, 1); PG8_STAGE(PG8_SA(0, 0), a2, voffA);
            PG8_BAR; PG8_WAIT_L(0); PG8_MMA(1, 0, At, B0); PG8_BAR; PG8_SCHED;
            PG8_STAGE(PG8_SB(0, 1), b2 + hstep, voffB);
            PG8_WAIT_V(6); PG8_BAR; PG8_MMA(1, 1, At, B1); PG8_BAR;
            PG8_LDB(B0, 1, 0); PG8_SCHED; PG8_LDA(At, 1, 0); PG8_STAGE(PG8_SA(0, 1), a2 + hstep, voffA);
            PG8_WAIT_L(8); PG8_BAR; PG8_WAIT_L(0); PG8_MMA(0, 0, At, B0); PG8_BAR; PG8_SCHED;
            PG8_LDB(B1, 1, 1); PG8_STAGE(PG8_SB(1, 0), b3, voffB);
            PG8_BAR; PG8_WAIT_L(0); PG8_MMA(0, 1, At, B1); PG8_BAR;
            PG8_LDA(At, 1, 1); PG8_STAGE(PG8_SA(1, 0), a3, voffA);
            PG8_BAR; PG8_WAIT_L(0); PG8_MMA(1, 0, At, B0); PG8_BAR; PG8_SCHED;
            PG8_STAGE(PG8_SB(1, 1), b3 + hstep, voffB);
            PG8_WAIT_V(6); PG8_BAR; PG8_MMA(1, 1, At, B1); PG8_BAR;
        }
        E(acc, cur, wr, wc, fr, fq);
        if (!has_next) break;
#pragma unroll
        for (int a = 0; a < 2; ++a)
#pragma unroll
            for (int b = 0; b < 2; ++b)
#pragma unroll
                for (int m = 0; m < 4; ++m)
#pragma unroll
                    for (int n = 0; n < 2; ++n) acc[a][b][m][n] = (f32x4){0.f, 0.f, 0.f, 0.f};
        cur = nxt; cA = nA; cB = nB; ++ui;
    }
    PG8_WAIT_V(0);
    if (wr == 0) PG8_BAR;
    PG8_BAR;
#undef PG8_SA
#undef PG8_SB
#undef PG8_STAGE
#undef PG8_LDA
#undef PG8_LDB
#undef PG8_MMA
#undef PG8_WAIT_V
#undef PG8_WAIT_L
#undef PG8_BAR
#undef PG8_SCHED
}
}

__device__ __forceinline__ void transpose_tile(const float* __restrict__ src, int ldsrc, int k0, int c0, bf16_t* __restrict__ dst, int lddst, int n0, float sc = 1.0f, const float* __restrict__ kscale = nullptr) {
    const int lane = threadIdx.x & 63;
    const float* p = src + (size_t)k0 * ldsrc + c0 + lane;
    float v[32];
#pragma unroll
    for (int k = 0; k < 32; ++k) v[k] = p[(size_t)k * ldsrc];
    if (kscale) {
#pragma unroll
        for (int k = 0; k < 32; ++k) v[k] *= kscale[k0 + k];
    }
    bf16_t* q = dst + (size_t)(n0 + lane) * lddst + k0;
#pragma unroll
    for (int c = 0; c < 4; ++c) { u32x4 w; w.x = cvt_pk_bf16(v[8 * c] * sc, v[8 * c + 1] * sc); w.y = cvt_pk_bf16(v[8 * c + 2] * sc, v[8 * c + 3] * sc);
        w.z = cvt_pk_bf16(v[8 * c + 4] * sc, v[8 * c + 5] * sc); w.w = cvt_pk_bf16(v[8 * c + 6] * sc, v[8 * c + 7] * sc);
        *(u32x4*)(q + 8 * c) = w; }
}

__device__ __forceinline__ void phase_prep(const Args& a, unsigned char* shm) {
    bf16_t* WA = (bf16_t*)(a.ws + WS_WA); bf16_t* WV = (bf16_t*)(a.ws + WS_WV); bf16_t* WO = (bf16_t*)(a.ws + WS_WO);
    bf16_t* WGU = (bf16_t*)(a.ws + WS_WGU); bf16_t* WD = (bf16_t*)(a.ws + WS_WD);
    for (int ti = blockIdx.x * 8 + (threadIdx.x >> 6); ti < 6272; ti += gridDim.x * 8) {
        if (ti < 1024) { const int nt_ = ti >> 5, kt = ti & 31; const int n0 = nt_ * 64;
            const int c0 = n0 < 1024 ? n0 : (n0 < 1536 ? n0 + 512 : n0 + 1024);
            const float sc = n0 < 512 ? 0.125f * LOG2E : ((n0 >= 1280 && n0 < 1536) ? 0.125f : 1.0f);
            transpose_tile(a.w_in, 3072, kt * 32, c0, WA, 1024, n0, sc);
        } else if (ti < 1536) { const int q = ti - 1024, nt_ = q >> 5, kt = q & 31; const int n0 = nt_ * 64;
            const int c0 = n0 < 512 ? 1024 + n0 : n0 + 1536;
            transpose_tile(a.w_in, 3072, kt * 32, c0, WV, 1024, n0);
        } else if (ti < 2048) { const int q = ti - 1536, nt_ = q >> 5, kt = q & 31;
            transpose_tile(a.w_out, 1024, kt * 32, nt_ * 64, WO, 1024, nt_ * 64);
        } else if (ti < 4864) { const int q = ti - 2048, nt_ = q >> 5, kt = q & 31; const int n0 = nt_ * 64;
            const int P = n0 >> 8, bj = (n0 >> 7) & 1, j0 = n0 & 127;
            transpose_tile(bj ? a.w_up : a.w_gate, DFF, kt * 32, P * 128 + j0, WGU, 1024, n0, 1.0f, a.pre_ffn_g);
        } else { const int q = ti - 4864, nt_ = q / 88, kt = q % 88;
            transpose_tile(a.w_down, 1024, kt * 32, nt_ * 64, WD, DFF, nt_ * 64);
        }
    }
    { u32x4* z = (u32x4*)(a.ws + WS_STAT); const u32x4 zero = {0u, 0u, 0u, 0u};
      for (size_t i = (size_t)blockIdx.x * 512 + threadIdx.x; i < STAT_BYTES / 16; i += (size_t)gridDim.x * 512) z[i] = zero; }
    bf16_t* H = (bf16_t*)(a.ws + WS_H);
    const int wv = threadIdx.x >> 6, lane = threadIdx.x & 63;
    const f32x4 g0 = *(const f32x4*)(a.pre_mix_g + 8 * lane), g1 = *(const f32x4*)(a.pre_mix_g + 8 * lane + 4);
    const f32x4 g2 = *(const f32x4*)(a.pre_mix_g + 512 + 8 * lane), g3 = *(const f32x4*)(a.pre_mix_g + 512 + 8 * lane + 4);
    constexpr int R0 = 4;
    for (int rowb = (blockIdx.x * 8 + wv) * R0; rowb < MTOK; rowb += gridDim.x * 8 * R0) {
        f32x4 xv[R0][4];
#pragma unroll
        for (int rr = 0; rr < R0; ++rr) { const float* xr = a.x + (size_t)(rowb + rr) * DM;
            xv[rr][0] = __builtin_nontemporal_load((const f32x4*)(xr + 8 * lane)); xv[rr][1] = __builtin_nontemporal_load((const f32x4*)(xr + 8 * lane + 4));
            xv[rr][2] = __builtin_nontemporal_load((const f32x4*)(xr + 512 + 8 * lane)); xv[rr][3] = __builtin_nontemporal_load((const f32x4*)(xr + 512 + 8 * lane + 4)); }
#pragma unroll
        for (int rr = 0; rr < R0; ++rr) {
            const f32x4 x0 = xv[rr][0], x1 = xv[rr][1], x2 = xv[rr][2], x3 = xv[rr][3];
            float ss = 0.f;
#pragma unroll
            for (int j = 0; j < 4; ++j) ss += x0[j] * x0[j] + x1[j] * x1[j] + x2[j] * x2[j] + x3[j] * x3[j];
            ss = wave_sum(ss);
            const float rn = __frsqrt_rn(ss * (1.0f / DM) + EPS);
            u32x4 w0, w1;
            w0.x = cvt_pk_bf16(x0[0] * rn * g0[0], x0[1] * rn * g0[1]); w0.y = cvt_pk_bf16(x0[2] * rn * g0[2], x0[3] * rn * g0[3]);
            w0.z = cvt_pk_bf16(x1[0] * rn * g1[0], x1[1] * rn * g1[1]); w0.w = cvt_pk_bf16(x1[2] * rn * g1[2], x1[3] * rn * g1[3]);
            w1.x = cvt_pk_bf16(x2[0] * rn * g2[0], x2[1] * rn * g2[1]); w1.y = cvt_pk_bf16(x2[2] * rn * g2[2], x2[3] * rn * g2[3]);
            w1.z = cvt_pk_bf16(x3[0] * rn * g3[0], x3[1] * rn * g3[1]); w1.w = cvt_pk_bf16(x3[2] * rn * g3[2], x3[3] * rn * g3[3]);
            *(u32x4*)(H + (size_t)(rowb + rr) * DM + 8 * lane) = w0; *(u32x4*)(H + (size_t)(rowb + rr) * DM + 512 + 8 * lane) = w1;
        }
    }
}

__device__ __forceinline__ void unpack8(const u32x4 w, float (&v)[8]) {
    v[0] = bf_lo(w.x); v[1] = bf_hi(w.x); v[2] = bf_lo(w.y); v[3] = bf_hi(w.y); v[4] = bf_lo(w.z); v[5] = bf_hi(w.z); v[6] = bf_lo(w.w); v[7] = bf_hi(w.w);
}

constexpr int AT_STAGE = 49152;
constexpr int AT_VOFF = 16384;

template <int TYPE>
__device__ __forceinline__ void attn_unit(const Args& a, unsigned char* lds, int b, int hsel, int qblk, float lam) {
    int tid_ = threadIdx.x; asm volatile("" : "+v"(tid_));
    const int tid = tid_, wv = tid >> 6, lane = tid & 63, r = lane & 31, hh = lane >> 5;
    const int g = wv >> 2, wq = wv & 3;
    const bf16_t* QK = (const bf16_t*)(a.ws + WS_QK); const bf16_t* VT = (const bf16_t*)(a.ws + WS_VT); bf16_t* OMIX = (bf16_t*)(a.ws + WS_OMIX);
    const int tok0 = b * SEQ, q0 = TYPE == 0 ? qblk * 128 : qblk * 256 + g * 128;
    int qcol, vrow0;
    if (TYPE == 0) { qcol = hsel * 128 + g * 64; vrow0 = hsel * 128; }
    else { qcol = 1024 + hsel * 64; vrow0 = 512 + hsel * 128; }
    const int head = hsel;
    float c2;
    if (TYPE == 0) c2 = exp2f(-2.0f * (float)(head + 1)) * LOG2E;
    else c2 = log2f(1.0f - exp2f(-5.0f - (float)head));
    float c7[8], c4[4];
#pragma unroll
    for (int k = 0; k < 8; ++k) { const float v = TYPE == 0 ? c2 * (float)k : exp2f(-c2 * (float)k); c7[k] = __uint_as_float(__builtin_amdgcn_readfirstlane(__float_as_uint(v))); }
#pragma unroll
    for (int k = 0; k < 4; ++k) { const float v = TYPE == 0 ? c2 * (float)(16 * k) : exp2f(-c2 * (float)(16 * k)); c4[k] = __uint_as_float(__builtin_amdgcn_readfirstlane(__float_as_uint(v))); }
    const int qrow = q0 + wq * 32 + r;
    const float qposf = (float)qrow;
    bf16x8 qf[4];
    { const bf16_t* qp = QK + (size_t)(tok0 + qrow) * 2048 + qcol + hh * 8;
#pragma unroll
      for (int s = 0; s < 4; ++s) qf[s] = *(const bf16x8*)(qp + 16 * s); }
    f32x16 O[4];
#pragma unroll
    for (int d = 0; d < 4; ++d)
#pragma unroll
        for (int i = 0; i < 16; ++i) O[d][i] = 0.f;
    float m_run = -1e30f, l_run = 0.f;
    const int mychunk = TYPE == 0 ? 2 * qblk + (wq >> 1) : 4 * qblk + 2 * g + (wq >> 1), nsteps = TYPE == 0 ? 2 * (qblk + 1) : 4 * (qblk + 1);
    const int rs = (r & 0x13) | ((r & 4) << 1) | ((r & 8) >> 1);
    constexpr int KT = TYPE == 0 ? 8192 : 4096, VOFF = TYPE == 0 ? AT_VOFF : 8192;
    int kx[4], vx[4];
#pragma unroll
    for (int s = 0; s < 4; ++s) { kx[s] = TYPE == 0 ? rs * 256 + ((((g * 8 + hh) ^ (rs & 15)) ^ (2 * s)) << 4) : rs * 128 + ((((2 * s) + hh) ^ ((rs >> 1) & 7)) << 4);
        vx[s] = VOFF + r * 128 + (((hh ^ ((r >> 1) & 7)) ^ (2 * s)) << 4); }
    constexpr int NV = 2, NK = TYPE == 0 ? 2 : 1, NI = NK + NV;
    const int wvu = __builtin_amdgcn_readfirstlane(wv);
    const bf16_t* K2 = (const bf16_t*)(a.ws + WS_K2);
    const bf16_t* kt0 = K2 + ((size_t)(tok0 >> 6) * 6 + (TYPE == 0 ? hsel : 4 + (hsel >> 1))) * 8192 + (TYPE == 0 ? 0 : (hsel & 1) * 64);
    const bf16_t* vt0 = VT + ((size_t)(tok0 >> 6) * VT_ROWS + vrow0) * 64;
    unsigned kgo[NK], vgo[NV];
#pragma unroll
    for (int i = 0; i < NK; ++i) { if (TYPE == 0) { const int row = (wv * 2 + i) * 4 + (lane >> 4); kgo[i] = (unsigned)(row * 128 + (((lane & 15) ^ (row & 15)) << 3)) * 2u; }
        else { const int row = wv * 8 + (lane >> 3); kgo[i] = (unsigned)(row * 128 + (((lane & 7) ^ ((row >> 1) & 7)) << 3)) * 2u; } }
#pragma unroll
    for (int i = 0; i < NV; ++i) { const int row = (wv * NV + i) * 8 + (lane >> 3); vgo[i] = (unsigned)(row * 64 + (((lane & 7) ^ ((row >> 1) & 7)) << 3)) * 2u; }
    LAS unsigned char* ldsl = (LAS unsigned char*)lds;
#define AT_GLDS(j, stoff) do { const char* _kb = (const char*)(kt0 + (size_t)(j) * (6 * 8192)); const char* _vb = (const char*)(vt0 + (size_t)(j) * (VT_ROWS * 64)); \
        _Pragma("unroll") for (int _i = 0; _i < NK; ++_i) __builtin_amdgcn_global_load_lds((const unsigned*)(_kb + kgo[_i]), (LAS unsigned*)(ldsl + (stoff) + (wvu * NK + _i) * 1024), 16, 0, 0); \
        _Pragma("unroll") for (int _i = 0; _i < NV; ++_i) __builtin_amdgcn_global_load_lds((const unsigned*)(_vb + vgo[_i]), (LAS unsigned*)(ldsl + (stoff) + VOFF + (wvu * NV + _i) * 1024), 16, 0, 0); } while (0)
#pragma unroll
    for (int s = 0; s < 4; ++s) asm volatile("" : "+v"(qf[s]));
#define AT_PV(stp, PK) do { bf16x8 _av[16]; __builtin_amdgcn_s_setprio(1); \
        _Pragma("unroll") for (int t = 0; t < 2; ++t) _Pragma("unroll") for (int s2 = 0; s2 < 2; ++s2) _Pragma("unroll") for (int d = 0; d < 4; ++d) \
            _av[(2 * t + s2) * 4 + d] = *(const bf16x8*)((stp) + vx[2 * t + s2] + d * 4096); \
        _Pragma("unroll") for (int t = 0; t < 2; ++t) _Pragma("unroll") for (int s2 = 0; s2 < 2; ++s2) _Pragma("unroll") for (int d = 0; d < 4; ++d) \
            O[d] = __builtin_amdgcn_mfma_f32_32x32x16_bf16(_av[(2 * t + s2) * 4 + d], PK[t][s2], O[d], 0, 0, 0); \
        __builtin_amdgcn_sched_group_barrier(0x100, 4, 0); \
        _Pragma("unroll") for (int _q = 0; _q < 12; ++_q) { __builtin_amdgcn_sched_group_barrier(0x008, 1, 0); __builtin_amdgcn_sched_group_barrier(0x100, 1, 0); } \
        __builtin_amdgcn_sched_group_barrier(0x008, 4, 0); __builtin_amdgcn_s_setprio(0); } while (0)
    constexpr int NST = 4, STSZ = TYPE == 0 ? 32768 : 24576;
    const bool rot = g == 1;
    bf16x8 pk[2][2];
#pragma unroll
    for (int t = 0; t < 2; ++t)
#pragma unroll
        for (int s2 = 0; s2 < 2; ++s2) pk[t][s2] = (bf16x8){0, 0, 0, 0, 0, 0, 0, 0};
    bool live_c = false; const unsigned char* st_c = lds;
    AT_GLDS(nsteps - 1, 0); AT_GLDS(nsteps - 2, STSZ);
    int st_cur = 0, st_nx = 2 * STSZ;
    for (int jj = 0; jj < nsteps; ++jj) {
        const int j = nsteps - 1 - jj;
        if (jj + 1 < nsteps) { if (NI == 4) asm volatile("s_waitcnt vmcnt(4)" ::: "memory"); else asm volatile("s_waitcnt vmcnt(3)" ::: "memory"); }
        else asm volatile("s_waitcnt vmcnt(0)" ::: "memory");
        __builtin_amdgcn_s_barrier();
        asm volatile("" ::: "memory");
        if (jj + 2 < nsteps) AT_GLDS(j - 2, st_nx);
        const unsigned char* st = lds + st_cur;
        st_cur = st_cur == (NST - 1) * STSZ ? 0 : st_cur + STSZ; st_nx = st_nx == (NST - 1) * STSZ ? 0 : st_nx + STSZ;
        if (rot && live_c) AT_PV(st_c, pk);
        bool live = false;
        if (j <= mychunk) {
            f32x16 S0, S1;
#pragma unroll
            for (int i = 0; i < 16; ++i) { S0[i] = 0.f; S1[i] = 0.f; }
            { bf16x8 ka[8]; __builtin_amdgcn_s_setprio(1);
#pragma unroll
              for (int s = 0; s < 4; ++s) { ka[2 * s] = *(const bf16x8*)(st + kx[s]); ka[2 * s + 1] = *(const bf16x8*)(st + kx[s] + KT); }
#pragma unroll
              for (int s = 0; s < 4; ++s) { S0 = __builtin_amdgcn_mfma_f32_32x32x16_bf16(ka[2 * s], qf[s], S0, 0, 0, 0);
                  S1 = __builtin_amdgcn_mfma_f32_32x32x16_bf16(ka[2 * s + 1], qf[s], S1, 0, 0, 0); }
              __builtin_amdgcn_sched_group_barrier(0x100, 4, 0);
#pragma unroll
              for (int q_ = 0; q_ < 4; ++q_) { __builtin_amdgcn_sched_group_barrier(0x008, 1, 0); __builtin_amdgcn_sched_group_barrier(0x100, 1, 0); }
              __builtin_amdgcn_sched_group_barrier(0x008, 4, 0); __builtin_amdgcn_s_setprio(0); }
            MFMA_GUARD(S0, S1);
            const float d0 = (float)(64 * j + 8 * hh) - qposf;
            float gadd[4];
            live = true;
            if (TYPE == 0) {
                if (j == mychunk) {
#pragma unroll
                    for (int i = 0; i < 16; ++i) { const float off = (float)(16 * (i >> 3) + (i & 7));
                        S0[i] -= c2 * fabsf(d0 + off); S1[i] -= c2 * fabsf(d0 + off + 32.0f); }
#pragma unroll
                    for (int k = 0; k < 4; ++k) gadd[k] = 0.f;
                } else {
#pragma unroll
                    for (int i = 0; i < 16; ++i) { S0[i] = a_adds(c7[i & 7], S0[i]); S1[i] = a_adds(c7[i & 7], S1[i]); }
                    const float base = c2 * d0;
#pragma unroll
                    for (int k = 0; k < 4; ++k) gadd[k] = base + c4[k];
                }
                float m0 = a_max3(S0[0], S0[1], S0[2]), m1 = a_max3(S0[8], S0[9], S0[10]), m2 = a_max3(S1[0], S1[1], S1[2]), m3 = a_max3(S1[8], S1[9], S1[10]);
                m0 = a_max3(m0, S0[3], S0[4]); m1 = a_max3(m1, S0[11], S0[12]); m2 = a_max3(m2, S1[3], S1[4]); m3 = a_max3(m3, S1[11], S1[12]);
                m0 = a_max3(m0, S0[5], S0[6]); m1 = a_max3(m1, S0[13], S0[14]); m2 = a_max3(m2, S1[5], S1[6]); m3 = a_max3(m3, S1[13], S1[14]);
                m0 = a_max(m0, S0[7]); m1 = a_max(m1, S0[15]); m2 = a_max(m2, S1[7]); m3 = a_max(m3, S1[15]);
                float mx = a_max3(a_add(m0, gadd[0]), a_add(m1, gadd[1]), a_max(a_add(m2, gadd[2]), a_add(m3, gadd[3])));
                mx = half_max(mx);
                if (__all(mx < m_run - 40.0f)) live = false;
                else {
                    if (!__all(mx <= m_run + 8.0f)) {
                        const float mn = fmaxf(m_run, mx); const float alpha = __builtin_amdgcn_exp2f(m_run - mn); m_run = mn; l_run *= alpha;
#pragma unroll
                        for (int d = 0; d < 4; ++d)
#pragma unroll
                            for (int i = 0; i < 16; ++i) O[d][i] *= alpha;
                    }
                    const float g0 = gadd[0] - m_run, g1 = gadd[1] - m_run, g2 = gadd[2] - m_run, g3 = gadd[3] - m_run;
                    float pa = 0.f, pb = 0.f, pc = 0.f, pd = 0.f;
#pragma unroll
                    for (int i = 0; i < 8; ++i) { S0[i] = __builtin_amdgcn_exp2f(a_add(S0[i], g0)); S0[8 + i] = __builtin_amdgcn_exp2f(a_add(S0[8 + i], g1));
                        S1[i] = __builtin_amdgcn_exp2f(a_add(S1[i], g2)); S1[8 + i] = __builtin_amdgcn_exp2f(a_add(S1[8 + i], g3));
                        pa = a_add(pa, S0[i]); pb = a_add(pb, S0[8 + i]); pc = a_add(pc, S1[i]); pd = a_add(pd, S1[8 + i]); }
                    l_run += a_add(a_add(pa, pb), a_add(pc, pd));
                }
            } else {
                if (j == mychunk) {
#pragma unroll
                    for (int i = 0; i < 16; ++i) { const float off = (float)(16 * (i >> 3) + (i & 7));
                        S0[i] *= __builtin_amdgcn_exp2f(c2 * fabsf(d0 + off)); S1[i] *= __builtin_amdgcn_exp2f(c2 * fabsf(d0 + off + 32.0f)); }
                } else {
                    const float fl = __builtin_amdgcn_exp2f(-c2 * d0);
                    const float g0 = fl * c4[0], g1 = fl * c4[1], g2 = fl * c4[2], g3 = fl * c4[3];
#pragma unroll
                    for (int i = 0; i < 8; ++i) { S0[i] = a_mul(a_muls(c7[i], S0[i]), g0); S0[8 + i] = a_mul(a_muls(c7[i], S0[8 + i]), g1); S1[i] = a_mul(a_muls(c7[i], S1[i]), g2); S1[8 + i] = a_mul(a_muls(c7[i], S1[8 + i]), g3); }
                }
            }
            if (live) {
#pragma unroll
                for (int s2 = 0; s2 < 2; ++s2) {
                    u32x4 w0, w1;
                    w0.x = cvt_pk_bf16(S0[8 * s2], S0[8 * s2 + 1]); w0.y = cvt_pk_bf16(S0[8 * s2 + 2], S0[8 * s2 + 3]); w0.z = cvt_pk_bf16(S0[8 * s2 + 4], S0[8 * s2 + 5]); w0.w = cvt_pk_bf16(S0[8 * s2 + 6], S0[8 * s2 + 7]);
                    w1.x = cvt_pk_bf16(S1[8 * s2], S1[8 * s2 + 1]); w1.y = cvt_pk_bf16(S1[8 * s2 + 2], S1[8 * s2 + 3]); w1.z = cvt_pk_bf16(S1[8 * s2 + 4], S1[8 * s2 + 5]); w1.w = cvt_pk_bf16(S1[8 * s2 + 6], S1[8 * s2 + 7]);
                    pk[0][s2] = *reinterpret_cast<bf16x8*>(&w0); pk[1][s2] = *reinterpret_cast<bf16x8*>(&w1);
                }
                if (!rot) AT_PV(st, pk);
            }
        }
        live_c = live; st_c = st;
    }
    if (rot && live_c) AT_PV(st_c, pk);
    __syncthreads();
#undef AT_GLDS
#undef AT_PV
    const size_t tokb = (size_t)(tok0 + q0 + wq * 32);
    constexpr int TPITCH = 272;
    if (TYPE == 0) {
        const float lt = half_sum(l_run);
        float* comb = (float*)lds;
        if (g == 1) { const float sc = lam / lt;
#pragma unroll
            for (int d = 0; d < 4; ++d)
#pragma unroll
                for (int i = 0; i < 16; ++i) comb[(wq * 64 + d * 16 + i) * 64 + lane] = O[d][i] * sc; }
        __syncthreads();
        if (g == 0) { const float inv = 1.0f / lt; float ss = 0.f;
#pragma unroll
            for (int d = 0; d < 4; ++d)
#pragma unroll
                for (int i = 0; i < 16; ++i) { const float v = O[d][i] * inv - comb[(wq * 64 + d * 16 + i) * 64 + lane]; O[d][i] = v; ss += v * v; }
            ss = half_sum(ss);
            const float rn = __frsqrt_rn(ss * (1.0f / 128.0f) + EPS) * 0.8f;
            unsigned char* tile = lds + 65536 + wq * (32 * TPITCH);
#pragma unroll
            for (int d = 0; d < 4; ++d)
#pragma unroll
                for (int q4 = 0; q4 < 4; ++q4) { const int dv = 32 * d + 8 * q4 + 4 * hh;
                    const f32x4 gv = *(const f32x4*)(a.subln_g + dv);
                    u32x2 w; w.x = cvt_pk_bf16(O[d][4 * q4] * rn * gv[0], O[d][4 * q4 + 1] * rn * gv[1]); w.y = cvt_pk_bf16(O[d][4 * q4 + 2] * rn * gv[2], O[d][4 * q4 + 3] * rn * gv[3]);
                    *(u32x2*)(tile + r * TPITCH + dv * 2) = w; }
            bf16_t* op = OMIX + tokb * DM + hsel * 128 + (lane & 15) * 8;
#pragma unroll
            for (int k = 0; k < 8; ++k) { const int row = 4 * k + (lane >> 4);
                const u32x4 v = *(const u32x4*)(tile + row * TPITCH + (lane & 15) * 16);
                *(u32x4*)(op + (size_t)row * DM) = v; } }
        __syncthreads();
    } else {
        const bf16_t* gp = QK + tokb * 2048 + 1536 + head * 128 + (lane & 15) * 8;
        u32x4 gw[8];
#pragma unroll
        for (int k = 0; k < 8; ++k) gw[k] = *(const u32x4*)(gp + (size_t)(4 * k + (lane >> 4)) * 2048);
        float ss = 0.f;
#pragma unroll
        for (int d = 0; d < 4; ++d)
#pragma unroll
            for (int i = 0; i < 16; ++i) ss += O[d][i] * O[d][i];
        ss = half_sum(ss);
        const float rn = __frsqrt_rn(ss * (1.0f / 128.0f) + EPS);
        unsigned char* tile = lds + 49152 + wv * (32 * TPITCH);
#pragma unroll
        for (int d = 0; d < 4; ++d)
#pragma unroll
            for (int q4 = 0; q4 < 4; ++q4) { const int dv = 32 * d + 8 * q4 + 4 * hh;
                const f32x4 gv = *(const f32x4*)(a.ret_g + dv);
                u32x2 w; w.x = cvt_pk_bf16(O[d][4 * q4] * rn * gv[0], O[d][4 * q4 + 1] * rn * gv[1]); w.y = cvt_pk_bf16(O[d][4 * q4 + 2] * rn * gv[2], O[d][4 * q4 + 3] * rn * gv[3]);
                *(u32x2*)(tile + r * TPITCH + dv * 2) = w; }
        bf16_t* op = OMIX + tokb * DM + 512 + head * 128 + (lane & 15) * 8;
#pragma unroll
        for (int k = 0; k < 8; ++k) { const int row = 4 * k + (lane >> 4);
            const u32x4 v = *(const u32x4*)(tile + row * TPITCH + (lane & 15) * 16);
            float vv[8], gg[8]; unpack8(v, vv); unpack8(gw[k], gg);
#pragma unroll
            for (int e = 0; e < 8; ++e) vv[e] *= gg[e] * __builtin_amdgcn_rcpf(1.0f + __builtin_amdgcn_exp2f(-gg[e] * LOG2E));
            u32x4 w; w.x = cvt_pk_bf16(vv[0], vv[1]); w.y = cvt_pk_bf16(vv[2], vv[3]); w.z = cvt_pk_bf16(vv[4], vv[5]); w.w = cvt_pk_bf16(vv[6], vv[7]);
            *(u32x4*)(op + (size_t)row * DM) = w; }
        __syncthreads();
    }
}

__device__ __forceinline__ void phase_mixer(const Args& a, unsigned char* lds, int segmask = 7) {
    unsigned* barw = (unsigned*)(a.ws + WS_BAR);
    bool xcc_ok = gridDim.x == 256;
    for (int j = 0; j < 16; ++j) { const unsigned c = xb_ld(&barw[XB_XCNT(j)]); xcc_ok = xcc_ok && (c == (j < 8 ? 32u : 0u)); }
    const unsigned my_rank = ((volatile LAS unsigned*)((LAS unsigned char*)lds + 3 * AT_STAGE))[2];
    const int slot_xcc = (int)(xb_xcc_id() * 32u + my_rank);

    const int lane = threadIdx.x & 63;
    const float d1 = wave_sum(a.lq1[lane] * a.lk1[lane]), d2 = wave_sum(a.lq2[lane] * a.lk2[lane]);
    const float lam = expf(d1) - expf(d2) + 0.2f;
    for (int i = blockIdx.x; i < 768; i += gridDim.x) {
        const int seg = i >> 8, w = i & 255, p = xcc_ok ? slot_xcc : (w & 7) * 32 + (w >> 3);
        if (!((segmask >> seg) & 1)) continue;
        if (seg < 2) { const int pp = seg * 256 + p, bh = pp >> 3, pi = pp & 7; const int hd = seg ? 3 - (bh & 3) : (bh & 3);
            attn_unit<0>(a, lds, bh >> 2, hd, pi, lam); attn_unit<0>(a, lds, bh >> 2, hd, 15 - pi, lam);
        } else { const int b = p >> 4, hd = (p >> 2) & 3, pi = p & 3;
            attn_unit<1>(a, lds, b, hd, pi, lam); attn_unit<1>(a, lds, b, hd, 7 - pi, lam); }
    }
}

__global__ void __launch_bounds__(512, 2) fwd_mega(Args a, int ph_lo, int ph_hi) {
    extern __shared__ __attribute__((aligned(16))) unsigned char shm[];
    cg::grid_group grid = cg::this_grid();
    bf16_t* WA = (bf16_t*)(a.ws + WS_WA); bf16_t* WV = (bf16_t*)(a.ws + WS_WV); bf16_t* WO = (bf16_t*)(a.ws + WS_WO);
    bf16_t* WGU = (bf16_t*)(a.ws + WS_WGU); bf16_t* WD = (bf16_t*)(a.ws + WS_WD); bf16_t* H = (bf16_t*)(a.ws + WS_H);
    bf16_t* QK = (bf16_t*)(a.ws + WS_QK); bf16_t* VT = (bf16_t*)(a.ws + WS_VT); bf16_t* OMIX = (bf16_t*)(a.ws + WS_OMIX);
    bf16_t* MIXB = (bf16_t*)(a.ws + WS_MIXB); bf16_t* F = (bf16_t*)(a.ws + WS_F);
    LAS unsigned char* lds = (LAS unsigned char*)shm;
    volatile LAS unsigned* xbw = (volatile LAS unsigned*)(lds + 3 * AT_STAGE);
    if (threadIdx.x == 0) { xbw[0] = 0u; xbw[1] = 0u; xbw[2] = 0u; xbw[3] = 0u; }
    __syncthreads();
    const XcdBarrier xb = xcd_barrier_post((unsigned*)(a.ws + WS_BAR), xbw);
    if (threadIdx.x == 0) xbw[2] = xb_add(&xb.bar[XB_TKT(xb.x)], 1u);
    if (ph_hi > 1000) grid.sync();
#ifndef PHMASK
#define PHMASK 255
#endif
#ifndef DUP
#define DUP 0
#endif
#define PH_ON(k) (ph_lo <= (k) && (k) < ph_hi)
#define PH_SYNC(k) do { if (ph_lo < (k) && (k) < ph_hi) xcd_barrier(xb); } while (0)
    if ((PHMASK & 1) && PH_ON(0)) phase_prep(a, shm);
    if (DUP & 1) { xcd_barrier(xb); phase_prep(a, shm); }
    PH_SYNC(1);
    if ((PHMASK & 2) && PH_ON(1)) {
        { pg8::StaticOrder S; S.init(MTOK, 2048, (int)gridDim.x, (int)blockIdx.x);
          pg8::gemm_phase(lds, pg8::Gemm{H, WA, MTOK, 2048, DM}, S, pg8::EpiQK{QK, (bf16_t*)(a.ws + WS_K2)}); }
        { pg8::StaticOrder S2; S2.init(1024, MTOK, (int)gridDim.x, (int)blockIdx.x);
          pg8::gemm_phase(lds, pg8::Gemm{WV, H, 1024, MTOK, DM}, S2, pg8::EpiVT{VT}); }
    }
    if (DUP & 2) { xcd_barrier(xb);
        { pg8::StaticOrder S; S.init(MTOK, 2048, (int)gridDim.x, (int)blockIdx.x);
          pg8::gemm_phase(lds, pg8::Gemm{H, WA, MTOK, 2048, DM}, S, pg8::EpiQK{QK, (bf16_t*)(a.ws + WS_K2)}); }
        { pg8::StaticOrder S2; S2.init(1024, MTOK, (int)gridDim.x, (int)blockIdx.x);
          pg8::gemm_phase(lds, pg8::Gemm{WV, H, 1024, MTOK, DM}, S2, pg8::EpiVT{VT}); } }
    PH_SYNC(2);
    if ((PHMASK & 4) && PH_ON(2)) phase_mixer(a, shm);
    if (DUP & 4) { xcd_barrier(xb); phase_mixer(a, shm); }
    if (DUP & 256) { xcd_barrier(xb); phase_mixer(a, shm, 3); }
    if (DUP & 512) { xcd_barrier(xb); phase_mixer(a, shm, 4); }
    PH_SYNC(3);
    if ((PHMASK & 8) && PH_ON(3)) {
        pg8::StaticOrder S; S.init(MTOK, DM, (int)gridDim.x, (int)blockIdx.x);
        unsigned long long* ss = (unsigned long long*)(a.ws + WS_STAT); unsigned* cn = (unsigned*)(a.ws + WS_STAT + STAT_CNT_OFF);
        pg8::gemm_phase(lds, pg8::Gemm{OMIX, WO, MTOK, DM, DM}, S, pg8::EpiNormResNorm{a.x, MIXB, a.post_mix_g, ss, ss + MTOK, cn});
    }
    PH_SYNC(5);
    if ((PHMASK & 32) && PH_ON(5)) {
        pg8::StaticOrder S; S.init(MTOK, 2 * DFF, (int)gridDim.x, (int)blockIdx.x);
        pg8::gemm_phase(lds, pg8::Gemm{MIXB, WGU, MTOK, 2 * DFF, DM}, S, pg8::EpiSwiGLU{F, DFF, (unsigned long long*)(a.ws + WS_STAT) + MTOK});
    }
    if (DUP & 32) { xcd_barrier(xb);
        pg8::StaticOrder S; S.init(MTOK, 2 * DFF, (int)gridDim.x, (int)blockIdx.x);
        pg8::gemm_phase(lds, pg8::Gemm{MIXB, WGU, MTOK, 2 * DFF, DM}, S, pg8::EpiSwiGLU{F, DFF, (unsigned long long*)(a.ws + WS_STAT) + MTOK}); }
    PH_SYNC(6);
    if ((PHMASK & 64) && PH_ON(6)) {
        pg8::StaticOrder S; S.init(MTOK, DM, (int)gridDim.x, (int)blockIdx.x);
        pg8::gemm_phase(lds, pg8::Gemm{F, WD, MTOK, DM, DFF}, S, pg8::EpiNormRes{a.out, MIXB, a.post_ffn_g, (unsigned long long*)(a.ws + WS_STAT) + 2 * (size_t)MTOK, (unsigned*)(a.ws + WS_STAT + STAT_CNT_OFF) + 2 * 256 * 64});
    }
}

constexpr int LDS_BYTES = 3 * AT_STAGE + 16;

extern "C" void kernel_launch(void* const* d_in, const int* in_sizes, int n_in, void* d_out, int out_size, void* d_ws, size_t ws_size, hipStream_t stream) {
    static int grid_blocks = 0;
    if (!grid_blocks) {
        int dev = 0, cus = 0, per_cu = 0;
        hipGetDevice(&dev);
        hipDeviceGetAttribute(&cus, hipDeviceAttributeMultiprocessorCount, dev);
        if (hipFuncSetAttribute((const void*)fwd_mega, hipFuncAttributeMaxDynamicSharedMemorySize, LDS_BYTES) != hipSuccess) fprintf(stderr, "hipFuncSetAttribute failed\n");
        if (hipOccupancyMaxActiveBlocksPerMultiprocessor(&per_cu, (const void*)fwd_mega, 512, LDS_BYTES) != hipSuccess || per_cu < 1) { fprintf(stderr, "occupancy query: %d\n", per_cu); per_cu = 1; }
        (void)hipGetLastError();
        grid_blocks = cus * 1;
        if (ws_size < WS_END) fprintf(stderr, "workspace too small: %zu < %zu\n", ws_size, (size_t)WS_END);
    }
    if (hipMemsetAsync((char*)d_ws + WS_BAR, 0, 32768, stream) != hipSuccess) fprintf(stderr, "memset of the barrier words failed\n");
    Args a{};
    a.x = (const float*)d_in[0]; a.pre_mix_g = (const float*)d_in[1]; a.w_in = (const float*)d_in[2];
    a.lq1 = (const float*)d_in[3]; a.lk1 = (const float*)d_in[4]; a.lq2 = (const float*)d_in[5]; a.lk2 = (const float*)d_in[6];
    a.subln_g = (const float*)d_in[7]; a.ret_g = (const float*)d_in[8]; a.w_out = (const float*)d_in[9];
    a.post_mix_g = (const float*)d_in[10]; a.pre_ffn_g = (const float*)d_in[11];
    a.w_gate = (const float*)d_in[12]; a.w_up = (const float*)d_in[13]; a.w_down = (const float*)d_in[14]; a.post_ffn_g = (const float*)d_in[15];
    a.out = (float*)d_out; a.ws = (unsigned char*)d_ws;
    int ph_lo = 0, ph_hi = 8;
    void* args[] = {&a, &ph_lo, &ph_hi};
    hipError_t e = hipLaunchCooperativeKernel((const void*)fwd_mega, dim3(grid_blocks), dim3(512), args, LDS_BYTES, stream);
    if (e != hipSuccess) fprintf(stderr, "cooperative launch failed: %s (grid %d)\n", hipGetErrorString(e), grid_blocks);
}
```

```cpp
#include <hip/hip_runtime.h>
#include <hip/hip_cooperative_groups.h>
#include <cstdio>
namespace cg = cooperative_groups;

#define LAS __attribute__((address_space(3)))
typedef unsigned short bf16_t;
typedef short bf16x8 __attribute__((ext_vector_type(8)));
typedef float f32x4 __attribute__((ext_vector_type(4)));
typedef float f32x16 __attribute__((ext_vector_type(16)));
typedef unsigned u32x4 __attribute__((ext_vector_type(4)));
typedef unsigned u32x2 __attribute__((ext_vector_type(2)));

constexpr int MTOK = 32768, DM = 1024, SEQ = 2048, DFF = 2816;
constexpr float EPS = 1e-6f;
constexpr float LOG2E = 1.4426950408889634f;

constexpr size_t MiB = 1024 * 1024;
constexpr size_t WS_WA = 0;
constexpr size_t WS_WV = WS_WA + 4 * MiB;
constexpr size_t WS_WO = WS_WV + 2 * MiB;
constexpr size_t WS_WGU = WS_WO + 2 * MiB;
constexpr size_t WS_WD = WS_WGU + 11 * MiB;
constexpr size_t WS_H = WS_WD + 6 * MiB;
constexpr size_t WS_QK = WS_H + 64 * MiB;
constexpr size_t WS_VT = WS_QK + 128 * MiB;
constexpr int VT_ROWS = 1040;
constexpr size_t WS_OMIX = WS_VT + 72 * MiB;
constexpr size_t WS_MIXB = WS_OMIX + 64 * MiB;
constexpr size_t WS_F = WS_QK;
constexpr size_t WS_K2 = WS_MIXB + 64 * MiB;
constexpr size_t WS_BAR = WS_K2 + 48 * MiB;
constexpr size_t WS_STAT = WS_BAR + 32768;
constexpr size_t STAT_SS_BYTES = (size_t)MTOK * 8, STAT_CNT_OFF = 3 * STAT_SS_BYTES, STAT_BYTES = STAT_CNT_OFF + 3 * 256 * 256;
constexpr size_t WS_END = WS_STAT + STAT_BYTES;

struct Args {
    const float* x; const float* pre_mix_g; const float* w_in; const float* lq1; const float* lk1; const float* lq2; const float* lk2;
    const float* subln_g; const float* ret_g; const float* w_out; const float* post_mix_g; const float* pre_ffn_g;
    const float* w_gate; const float* w_up; const float* w_down; const float* post_ffn_g;
    float* out; unsigned char* ws;
};

__device__ __forceinline__ unsigned cvt_pk_bf16(float lo, float hi) { unsigned r; asm("v_cvt_pk_bf16_f32 %0, %1, %2" : "=v"(r) : "v"(lo), "v"(hi)); return r; }
__device__ __forceinline__ float bf_lo(unsigned w) { return __uint_as_float(w << 16); }
__device__ __forceinline__ float bf_hi(unsigned w) { return __uint_as_float(w & 0xffff0000u); }
__device__ __forceinline__ float a_add(float a, float b)  { float r; asm("v_add_f32_e32 %0, %1, %2" : "=v"(r) : "v"(a), "v"(b)); return r; }
__device__ __forceinline__ float a_adds(float s_, float b) { float r; asm("v_add_f32_e32 %0, %1, %2" : "=v"(r) : "s"(s_), "v"(b)); return r; }
__device__ __forceinline__ float a_mul(float a, float b)  { float r; asm("v_mul_f32_e32 %0, %1, %2" : "=v"(r) : "v"(a), "v"(b)); return r; }
__device__ __forceinline__ float a_muls(float s_, float b) { float r; asm("v_mul_f32_e32 %0, %1, %2" : "=v"(r) : "s"(s_), "v"(b)); return r; }
__device__ __forceinline__ float a_max(float a, float b)  { float r; asm("v_max_f32_e32 %0, %1, %2" : "=v"(r) : "v"(a), "v"(b)); return r; }
__device__ __forceinline__ float a_max3(float a, float b, float c) { float r; asm("v_max3_f32 %0, %1, %2, %3" : "=v"(r) : "v"(a), "v"(b), "v"(c)); return r; }
#define MFMA_GUARD(X, Y) asm volatile("s_nop 15\n\ts_nop 3" : "+v"(X), "+v"(Y))
__device__ __forceinline__ float half_sum(float v) { auto rr = __builtin_amdgcn_permlane32_swap(__float_as_uint(v), __float_as_uint(v), false, false); return __uint_as_float(rr[0]) + __uint_as_float(rr[1]); }
__device__ __forceinline__ float half_max(float v) { auto rr = __builtin_amdgcn_permlane32_swap(__float_as_uint(v), __float_as_uint(v), false, false); return fmaxf(__uint_as_float(rr[0]), __uint_as_float(rr[1])); }
__device__ __forceinline__ float wave_sum(float v) {
#pragma unroll
    for (int o = 32; o > 0; o >>= 1) v += __shfl_xor(v, o);
    return v;
}

#define XB_TMO      128
#define XB_XCNT(j)  (256  + 64 * (j))
#define XB_XSUB(j)  (1280 + 64 * (j))
#define XB_XGEN(j)  (2304 + 64 * (j))
#define XB_TOP      3328
#define XB_TOPGEN   3392
#define XCD_BAR_WORDS 3456
#define XB_TKT(j)   (3456 + 64 * (j))
#define XB_ALL_WORDS (3456 + 16 * 64)
#define XB_SPIN_CAP (1u << 18)
__device__ __forceinline__ unsigned xb_ld(unsigned* p)              { return __hip_atomic_load(p, __ATOMIC_RELAXED, __HIP_MEMORY_SCOPE_AGENT); }
__device__ __forceinline__ unsigned xb_add(unsigned* p, unsigned v) { return __hip_atomic_fetch_add(p, v, __ATOMIC_RELAXED, __HIP_MEMORY_SCOPE_AGENT); }
__device__ __forceinline__ unsigned xb_xcc_id() { return (unsigned)__builtin_amdgcn_s_getreg((3 << 11) | 20) & 0xFu; }
#define XB_SPIN(cond, bar) do { unsigned _sp = 0; while (cond) { __builtin_amdgcn_s_sleep(1); \
    if ((++_sp & 255u) == 0u) { if (xb_ld(&(bar)[XB_TMO])) break; if (_sp > XB_SPIN_CAP) { atomicAdd(&(bar)[XB_TMO], 1u); break; } } } } while (0)
struct XcdBarrier { unsigned* bar; unsigned x; volatile LAS unsigned* st; };
__device__ __forceinline__ XcdBarrier xcd_barrier_post(unsigned* bar, volatile LAS unsigned* st) {
    XcdBarrier b; b.bar = bar; b.x = xb_xcc_id(); b.st = st;
    if (threadIdx.x == 0) (void)xb_add(&bar[XB_XCNT(b.x)], 1u);
    return b;
}
__device__ __forceinline__ void xcd_barrier_complete(unsigned* bar, unsigned x, unsigned& nloc, unsigned& nx) {
    const unsigned G = gridDim.x * gridDim.y * gridDim.z;
    unsigned sum, cnt, mine, sp = 0u;
    for (;;) {
        sum = 0u; cnt = 0u; mine = 0u;
#pragma unroll
        for (unsigned j = 0; j < 16; ++j) { const unsigned c = xb_ld(&bar[XB_XCNT(j)]); sum += c; cnt += (c > 0u) ? 1u : 0u; mine = (j == x) ? c : mine; }
        if (sum == G) break;
        __builtin_amdgcn_s_sleep(1);
        if ((++sp & 255u) == 0u) { if (xb_ld(&bar[XB_TMO])) break; if (sp > XB_SPIN_CAP) { atomicAdd(&bar[XB_TMO], 1u); break; } }
    }
    nloc = mine > 0u ? mine : 1u; nx = cnt > 0u ? cnt : 1u;
}
__device__ __forceinline__ void xcd_barrier(const XcdBarrier& b) {
    asm volatile("s_waitcnt vmcnt(0)" ::: "memory");
    __syncthreads();
    if (threadIdx.x == 0) {
        unsigned* bar = b.bar;
        __builtin_amdgcn_s_waitcnt(0);
        unsigned nloc = b.st[0], nx = b.st[1];
        if (nloc == 0u) { xcd_barrier_complete(bar, b.x, nloc, nx); b.st[0] = nloc; b.st[1] = nx; }
        const unsigned old = xb_add(&bar[XB_XSUB(b.x)], 1u);
        const unsigned gen = old / nloc;
        if (old + 1u == (gen + 1u) * nloc) {
            __builtin_amdgcn_fence(__ATOMIC_RELEASE, "agent");
            asm volatile("s_waitcnt vmcnt(0)" ::: "memory");
            const unsigned og = xb_add(&bar[XB_TOP], 1u);
            const unsigned tg = og / nx;
            if (og + 1u == (tg + 1u) * nx) xb_add(&bar[XB_TOPGEN], 1u);
            else XB_SPIN(xb_ld(&bar[XB_TOPGEN]) == tg, bar);
            __builtin_amdgcn_fence(__ATOMIC_ACQUIRE, "agent");
            xb_add(&bar[XB_XGEN(b.x)], 1u);
            asm volatile("s_waitcnt vmcnt(0)" ::: "memory");
        } else {
            XB_SPIN(xb_ld(&bar[XB_XGEN(b.x)]) == gen, bar);
            __builtin_amdgcn_fence(__ATOMIC_ACQUIRE, "agent");
            asm volatile("s_waitcnt vmcnt(0)" ::: "memory");
        }
    }
    __syncthreads();
}

namespace pg8 {
constexpr int BM = 256, BK = 64, HALF = 128, HTB = HALF * BK * 2, STAGE_BYTES = 8 * HTB, NXCD = 8, WGM = 8;
__host__ __device__ __forceinline__ int lds_byte(int r, int c) { const int st = (r >> 4) * 2 + (c >> 5), rr = r & 15, cc = c & 31, ob = rr * 64 + cc * 2; return st * 1024 + (ob ^ (((ob >> 9) & 1) << 5)); }
__host__ __device__ __forceinline__ void stage_rc(int b, int& R, int& C) { const int st = b / 1024, sb = b % 1024, swz = sb ^ (((sb >> 9) & 1) << 5); R = (st >> 1) * 16 + swz / 64; C = (st & 1) * 32 + (swz % 64) / 2; }
__host__ __device__ __forceinline__ int perm32(int rho) { const int n = rho >> 4, i = rho & 15; return 8 * (i >> 2) + 4 * n + (i & 3); }
struct Unit { int pm, pn; };
struct Gemm { const bf16_t* A; const bf16_t* Bt; int M, N, K; };
struct StaticOrder {
    int nM, nN, nwg, G, c;
    __host__ __device__ void init(int M, int N, int G_, int c_) { nM = M / BM; nN = N / BM; nwg = nM * nN; G = G_; c = c_; }
    __host__ __device__ bool next(int i, Unit& u) const {
        const long L = (long)i * G + c; if (L >= nwg) return false;
        int wgid = (int)L; { const int q = nwg / NXCD, r = nwg % NXCD, xcd = wgid % NXCD, off = wgid / NXCD; wgid = (xcd < r ? xcd * (q + 1) : r * (q + 1) + (xcd - r) * q) + off; }
        const int nig = WGM * nN, gid = wgid / nig, fm = gid * WGM, gsz = (nM - fm) < WGM ? (nM - fm) : WGM;
        u.pm = fm + ((wgid % nig) % gsz); u.pn = (wgid % nig) / gsz; return true;
    }
};

struct EpiBf16 {
    bf16_t* O; int ldc;
    __device__ __forceinline__ void operator()(const f32x4 (&acc)[2][2][4][2], const Unit& u, int wr, int wc, int fr, int fq) const {
        const int row0 = u.pm * BM + wr * 64 + fr; const int col0 = u.pn * BM + wc * 32 + 8 * fq;
#pragma unroll
        for (int ai = 0; ai < 2; ++ai)
#pragma unroll
            for (int m = 0; m < 4; ++m) { bf16_t* rowp = O + (size_t)(row0 + ai * HALF + m * 16) * ldc + col0;
#pragma unroll
                for (int bj = 0; bj < 2; ++bj) { const f32x4 v0 = acc[ai][bj][m][0], v1 = acc[ai][bj][m][1];
                    u32x4 w; w.x = cvt_pk_bf16(v0[0], v0[1]); w.y = cvt_pk_bf16(v0[2], v0[3]); w.z = cvt_pk_bf16(v1[0], v1[1]); w.w = cvt_pk_bf16(v1[2], v1[3]);
                    *(u32x4*)(rowp + bj * HALF) = w; } }
    }
};
struct EpiQK {
    bf16_t* O; bf16_t* K2;
    __device__ __forceinline__ void operator()(const f32x4 (&acc)[2][2][4][2], const Unit& u, int wr, int wc, int fr, int fq) const {
        const int row0 = u.pm * BM + wr * 64 + fr;
        const bool isk = (u.pn == 2) || (u.pn == 3) || (u.pn == 5);
        const int slot0 = u.pn == 5 ? 4 : (u.pn - 2) * 2;
#pragma unroll
        for (int ai = 0; ai < 2; ++ai)
#pragma unroll
            for (int m = 0; m < 4; ++m) { const int row = row0 + ai * HALF + m * 16;
#pragma unroll
                for (int bj = 0; bj < 2; ++bj) { const f32x4 v0 = acc[ai][bj][m][0], v1 = acc[ai][bj][m][1];
                    u32x4 w; w.x = cvt_pk_bf16(v0[0], v0[1]); w.y = cvt_pk_bf16(v0[2], v0[3]); w.z = cvt_pk_bf16(v1[0], v1[1]); w.w = cvt_pk_bf16(v1[2], v1[3]);
                    bf16_t* p = isk ? K2 + ((size_t)((row >> 6) * 6 + slot0 + bj) * 64 + (row & 63)) * 128 + wc * 32 + 8 * fq
                                    : O + (size_t)row * 2048 + u.pn * BM + bj * HALF + wc * 32 + 8 * fq;
                    *(u32x4*)p = w; } }
    }
};
struct EpiVT {
    bf16_t* V2;
    __device__ __forceinline__ void operator()(const f32x4 (&acc)[2][2][4][2], const Unit& u, int wr, int wc, int fr, int fq) const {
        const int row0 = u.pm * BM + wr * 64 + fr;
#pragma unroll
        for (int ai = 0; ai < 2; ++ai)
#pragma unroll
            for (int m = 0; m < 4; ++m) { const int row = row0 + ai * HALF + m * 16;
#pragma unroll
                for (int bj = 0; bj < 2; ++bj) { const f32x4 v0 = acc[ai][bj][m][0], v1 = acc[ai][bj][m][1];
                    u32x4 w; w.x = cvt_pk_bf16(v0[0], v0[1]); w.y = cvt_pk_bf16(v0[2], v0[3]); w.z = cvt_pk_bf16(v1[0], v1[1]); w.w = cvt_pk_bf16(v1[2], v1[3]);
                    const int T = u.pn * 4 + bj * 2 + (wc >> 1);
                    *(u32x4*)(V2 + ((size_t)T * VT_ROWS + row) * 64 + (wc & 1) * 32 + 8 * fq) = w; } }
    }
};
constexpr float SS_SCALE = 16777216.0f, SS_INV = 1.0f / 16777216.0f;
__device__ __forceinline__ void row_ss_publish(const float (&ps)[2][4], unsigned long long* rowss, unsigned* cnt, int row0, int fq, int lane) {
    if (fq == 0) {
#pragma unroll
        for (int ai = 0; ai < 2; ++ai)
#pragma unroll
            for (int m = 0; m < 4; ++m) (void)__hip_atomic_fetch_add(rowss + row0 + ai * HALF + m * 16, (unsigned long long)(ps[ai][m] * SS_SCALE), __ATOMIC_RELAXED, __HIP_MEMORY_SCOPE_AGENT);
    }
    asm volatile("s_waitcnt vmcnt(0)" ::: "memory");
    if (lane == 0) (void)__hip_atomic_fetch_add(cnt, 1u, __ATOMIC_RELAXED, __HIP_MEMORY_SCOPE_AGENT);
    unsigned spins = 0;
    while (__hip_atomic_load(cnt, __ATOMIC_RELAXED, __HIP_MEMORY_SCOPE_AGENT) < 16u) { __builtin_amdgcn_s_sleep(2); if (++spins > (1u << 22)) break; }
    asm volatile("" ::: "memory");
}
__device__ __forceinline__ void row_rn_fetch(float (&rn)[2][4], unsigned long long* rowss, int row0) {
#pragma unroll
    for (int ai = 0; ai < 2; ++ai)
#pragma unroll
        for (int m = 0; m < 4; ++m) { const unsigned long long t = __hip_atomic_load(rowss + row0 + ai * HALF + m * 16, __ATOMIC_RELAXED, __HIP_MEMORY_SCOPE_AGENT);
            rn[ai][m] = __frsqrt_rn((float)t * SS_INV * (1.0f / 1024.0f) + EPS); }
}
struct EpiNormRes {
    float* out; const bf16_t* X1B; const float* g; unsigned long long* rowss; unsigned* cnt;
    __device__ __forceinline__ void operator()(f32x4 (&acc)[2][2][4][2], const Unit& u, int wr, int wc, int fr, int fq) const {
        const int row0 = u.pm * BM + wr * 64 + fr, col0 = u.pn * BM + wc * 32 + 8 * fq, lane = fq * 16 + fr;
        float ps[2][4], rn[2][4];
#pragma unroll
        for (int ai = 0; ai < 2; ++ai)
#pragma unroll
            for (int m = 0; m < 4; ++m) { float t = 0.f;
#pragma unroll
                for (int bj = 0; bj < 2; ++bj)
#pragma unroll
                    for (int n = 0; n < 2; ++n)
#pragma unroll
                        for (int e = 0; e < 4; ++e) t += acc[ai][bj][m][n][e] * acc[ai][bj][m][n][e];
                t += __shfl_xor(t, 16); t += __shfl_xor(t, 32); ps[ai][m] = t; }
        u32x4 xpre[2][4][2];
#pragma unroll
        for (int ai = 0; ai < 2; ++ai)
#pragma unroll
            for (int m = 0; m < 4; ++m)
#pragma unroll
                for (int bj = 0; bj < 2; ++bj) xpre[ai][m][bj] = __builtin_nontemporal_load((const u32x4*)(X1B + (size_t)(row0 + ai * HALF + m * 16) * 1024 + col0 + bj * HALF));
        row_ss_publish(ps, rowss, cnt + (u.pm * 2 + wr) * 64, row0, fq, lane);
        row_rn_fetch(rn, rowss, row0);
#pragma unroll
        for (int ai = 0; ai < 2; ++ai)
#pragma unroll
            for (int m = 0; m < 4; ++m) { float* rowp = out + (size_t)(row0 + ai * HALF + m * 16) * 1024 + col0;
#pragma unroll
                for (int bj = 0; bj < 2; ++bj) { float* p = rowp + bj * HALF; const float* gp = g + col0 + bj * HALF;
                    const f32x4 g0 = *(const f32x4*)gp, g1 = *(const f32x4*)(gp + 4);
                    const u32x4 xw = xpre[ai][m][bj];
                    f32x4 x0 = (f32x4){bf_lo(xw.x), bf_hi(xw.x), bf_lo(xw.y), bf_hi(xw.y)}, x1 = (f32x4){bf_lo(xw.z), bf_hi(xw.z), bf_lo(xw.w), bf_hi(xw.w)};
                    x0 += acc[ai][bj][m][0] * rn[ai][m] * g0; x1 += acc[ai][bj][m][1] * rn[ai][m] * g1;
                    __builtin_nontemporal_store(x0, (f32x4*)p); __builtin_nontemporal_store(x1, (f32x4*)(p + 4)); } }
    }
};
struct EpiNormResNorm {
    const float* x; bf16_t* X1B; const float* g1; unsigned long long* rowss1; unsigned long long* rowss2; unsigned* cnt1;
    __device__ __forceinline__ void operator()(f32x4 (&acc)[2][2][4][2], const Unit& u, int wr, int wc, int fr, int fq) const {
        const int row0 = u.pm * BM + wr * 64 + fr, col0 = u.pn * BM + wc * 32 + 8 * fq, lane = fq * 16 + fr;
        float ps[2][4], rn[2][4];
#pragma unroll
        for (int ai = 0; ai < 2; ++ai)
#pragma unroll
            for (int m = 0; m < 4; ++m) { float t = 0.f;
#pragma unroll
                for (int bj = 0; bj < 2; ++bj)
#pragma unroll
                    for (int n = 0; n < 2; ++n)
#pragma unroll
                        for (int e = 0; e < 4; ++e) t += acc[ai][bj][m][n][e] * acc[ai][bj][m][n][e];
                t += __shfl_xor(t, 16); t += __shfl_xor(t, 32); ps[ai][m] = t; }
        row_ss_publish(ps, rowss1, cnt1 + (u.pm * 2 + wr) * 64, row0, fq, lane);
        row_rn_fetch(rn, rowss1, row0);
#pragma unroll
        for (int ai = 0; ai < 2; ++ai)
#pragma unroll
            for (int m = 0; m < 4; ++m) { const float* xrow = x + (size_t)(row0 + ai * HALF + m * 16) * 1024 + col0; float t = 0.f;
#pragma unroll
                for (int bj = 0; bj < 2; ++bj) { const float* gp = g1 + col0 + bj * HALF;
                    const f32x4 g0 = *(const f32x4*)gp, g1v = *(const f32x4*)(gp + 4);
                    const f32x4 x0 = __builtin_nontemporal_load((const f32x4*)(xrow + bj * HALF)), x1 = __builtin_nontemporal_load((const f32x4*)(xrow + bj * HALF + 4));
                    const f32x4 v0 = x0 + acc[ai][bj][m][0] * rn[ai][m] * g0, v1 = x1 + acc[ai][bj][m][1] * rn[ai][m] * g1v;
                    acc[ai][bj][m][0] = v0; acc[ai][bj][m][1] = v1;
#pragma unroll
                    for (int e = 0; e < 4; ++e) t += v0[e] * v0[e] + v1[e] * v1[e]; }
                t += __shfl_xor(t, 16); t += __shfl_xor(t, 32); ps[ai][m] = t; }
        if (fq == 0) {
#pragma unroll
            for (int ai = 0; ai < 2; ++ai)
#pragma unroll
                for (int m = 0; m < 4; ++m) (void)__hip_atomic_fetch_add(rowss2 + row0 + ai * HALF + m * 16, (unsigned long long)(ps[ai][m] * SS_SCALE), __ATOMIC_RELAXED, __HIP_MEMORY_SCOPE_AGENT);
        }
#pragma unroll
        for (int ai = 0; ai < 2; ++ai)
#pragma unroll
            for (int m = 0; m < 4; ++m) { const size_t ro = (size_t)(row0 + ai * HALF + m * 16) * 1024 + col0;
#pragma unroll
                for (int bj = 0; bj < 2; ++bj) { const f32x4 v0 = acc[ai][bj][m][0], v1 = acc[ai][bj][m][1];
                    u32x4 wx; wx.x = cvt_pk_bf16(v0[0], v0[1]); wx.y = cvt_pk_bf16(v0[2], v0[3]); wx.z = cvt_pk_bf16(v1[0], v1[1]); wx.w = cvt_pk_bf16(v1[2], v1[3]);
                    *(u32x4*)(X1B + ro + bj * HALF) = wx; } }
    }
};
__device__ __forceinline__ float silu_mul(float g, float u) { return g * u * __builtin_amdgcn_rcpf(1.0f + __builtin_amdgcn_exp2f(-g * LOG2E)); }
struct EpiSwiGLU {
    bf16_t* F; int ldf; const unsigned long long* rowss;
    __device__ __forceinline__ void operator()(const f32x4 (&acc)[2][2][4][2], const Unit& u, int wr, int wc, int fr, int fq) const {
        const int row0 = u.pm * BM + wr * 64 + fr; const int col0 = u.pn * HALF + wc * 32 + 8 * fq;
        float rn[2][4];
#pragma unroll
        for (int ai = 0; ai < 2; ++ai)
#pragma unroll
            for (int m = 0; m < 4; ++m) rn[ai][m] = __frsqrt_rn((float)rowss[row0 + ai * HALF + m * 16] * SS_INV * (1.0f / 1024.0f) + EPS);
#pragma unroll
        for (int ai = 0; ai < 2; ++ai)
#pragma unroll
            for (int m = 0; m < 4; ++m) { bf16_t* rowp = F + (size_t)(row0 + ai * HALF + m * 16) * ldf + col0; const float r = rn[ai][m];
                const f32x4 g0 = acc[ai][0][m][0] * r, g1 = acc[ai][0][m][1] * r, u0 = acc[ai][1][m][0] * r, u1 = acc[ai][1][m][1] * r;
                u32x4 w; w.x = cvt_pk_bf16(silu_mul(g0[0], u0[0]), silu_mul(g0[1], u0[1])); w.y = cvt_pk_bf16(silu_mul(g0[2], u0[2]), silu_mul(g0[3], u0[3]));
                w.z = cvt_pk_bf16(silu_mul(g1[0], u1[0]), silu_mul(g1[1], u1[1])); w.w = cvt_pk_bf16(silu_mul(g1[2], u1[2]), silu_mul(g1[3], u1[3]));
                *(u32x4*)rowp = w; }
    }
};

template <class Epi>
__device__ __forceinline__ void gemm_phase(LAS unsigned char* lds, const Gemm g, const StaticOrder& S, const Epi& E) {
    int tid_ = threadIdx.x; asm volatile("" : "+v"(tid_));
    const int tid = tid_, wid = __builtin_amdgcn_readfirstlane(tid >> 6), lane = tid & 63, wr = wid >> 2, wc = wid & 3, fr = lane & 15, fq = lane >> 4;
    const int K = g.K, nt = K / BK;
    unsigned voffA[2], voffB[2];
#pragma unroll
    for (int i = 0; i < 2; ++i) { int R, C; stage_rc(tid * 16 + i * 8192, R, C); const int Rb = (R & ~31) + perm32(R & 31);
        voffA[i] = (unsigned)(R * K + C) * 2u; voffB[i] = (unsigned)(Rb * K + C) * 2u; }
    const size_t kstep = (size_t)(BK * 2);
    const size_t hstep = (size_t)HALF * K * 2;
    const size_t tstep = 2 * hstep;
    const unsigned ldsw = (unsigned)wid * 1024u;
    const int aoff = lds_byte(wr * 64 + fr, fq * 8), boff = lds_byte(wc * 32 + fr, fq * 8);
#define PG8_SA(b, h) (((b) * 2 + (h)) * HTB)
#define PG8_SB(b, h) ((4 + (b) * 2 + (h)) * HTB)
#define PG8_STAGE(bufoff, gbase, voff) do { _Pragma("unroll") for (int _i = 0; _i < 2; ++_i) \
        __builtin_amdgcn_global_load_lds((const unsigned*)((const char*)(gbase) + (voff)[_i]), (LAS unsigned*)(lds + (bufoff) + ldsw + _i * 8192), 16, 0, 0); } while (0)
#define PG8_LDA(dst, b, h) do { _Pragma("unroll") for (int m = 0; m < 4; ++m) _Pragma("unroll") for (int k = 0; k < 2; ++k) dst[m][k] = *(const LAS bf16x8*)(lds + PG8_SA(b, h) + aoff + m * 2048 + k * 1024); } while (0)
#define PG8_LDB(dst, b, h) do { _Pragma("unroll") for (int n = 0; n < 2; ++n) _Pragma("unroll") for (int k = 0; k < 2; ++k) dst[n][k] = *(const LAS bf16x8*)(lds + PG8_SB(b, h) + boff + n * 2048 + k * 1024); } while (0)
#define PG8_MMA(ai, bj, At, Bt) do { __builtin_amdgcn_s_setprio(1); _Pragma("unroll") for (int m = 0; m < 4; ++m) _Pragma("unroll") for (int n = 0; n < 2; ++n) _Pragma("unroll") for (int k = 0; k < 2; ++k) \
        acc[ai][bj][m][n] = __builtin_amdgcn_mfma_f32_16x16x32_bf16(Bt[n][k], At[m][k], acc[ai][bj][m][n], 0, 0, 0); __builtin_amdgcn_s_setprio(0); } while (0)
#define PG8_WAIT_V(n) asm volatile("s_waitcnt vmcnt(" #n ")" ::: "memory")
#define PG8_WAIT_L(n) asm volatile("s_waitcnt lgkmcnt(" #n ")" ::: "memory")
#define PG8_BAR __builtin_amdgcn_s_barrier()
#define PG8_SCHED __builtin_amdgcn_sched_barrier(0)
    Unit cur, nxt; int ui = 0;
    if (!S.next(0, cur)) return;
    f32x4 acc[2][2][4][2];
#pragma unroll
    for (int a = 0; a < 2; ++a)
#pragma unroll
        for (int b = 0; b < 2; ++b)
#pragma unroll
            for (int m = 0; m < 4; ++m)
#pragma unroll
                for (int n = 0; n < 2; ++n) acc[a][b][m][n] = (f32x4){0.f, 0.f, 0.f, 0.f};
    bf16x8 At[4][2], B0[2][2], B1[2][2];
    const char* cA = (const char*)g.A + (size_t)cur.pm * tstep; const char* cB = (const char*)g.Bt + (size_t)cur.pn * tstep;
    PG8_STAGE(PG8_SB(0, 0), cB, voffB); PG8_STAGE(PG8_SA(0, 0), cA, voffA); PG8_STAGE(PG8_SB(0, 1), cB + hstep, voffB); PG8_STAGE(PG8_SA(0, 1), cA + hstep, voffA);
    if (wr == 1) PG8_BAR;
    PG8_WAIT_V(4); PG8_BAR;
    PG8_STAGE(PG8_SB(1, 0), cB + kstep, voffB); PG8_STAGE(PG8_SA(1, 0), cA + kstep, voffA); PG8_STAGE(PG8_SB(1, 1), cB + hstep + kstep, voffB);
    PG8_WAIT_V(6); PG8_BAR;
    for (;;) {
        const bool has_next = S.next(ui + 1, nxt);
        const char* nA = has_next ? (const char*)g.A + (size_t)nxt.pm * tstep : cA; const char* nB = has_next ? (const char*)g.Bt + (size_t)nxt.pn * tstep : cB;
        for (int t = 0; t < nt; t += 2) {
            const bool last = (t == nt - 2);
            const char* a1 = cA + (size_t)(t + 1) * kstep;
            const char* a2 = last ? nA : cA + (size_t)(t + 2) * kstep; const char* b2 = last ? nB : cB + (size_t)(t + 2) * kstep;
            const char* a3 = a2 + kstep; const char* b3 = b2 + kstep;
            PG8_LDB(B0, 0, 0); PG8_SCHED; PG8_LDA(At, 0, 0); PG8_STAGE(PG8_SA(1, 1), a1 + hstep, voffA);
            PG8_WAIT_L(8); PG8_BAR; PG8_WAIT_L(0); PG8_MMA(0, 0, At, B0); PG8_BAR; PG8_SCHED;
            PG8_LDB(B1, 0, 1); PG8_STAGE(PG8_SB(0, 0), b2, voffB);
            PG8_BAR; PG8_WAIT_L(0); PG8_MMA(0, 1, At, B1); PG8_BAR;
            PG8_LDA(At, 0, 1); PG8_STAGE(PG8_SA(0, 0), a2, voffA);
            PG8_BAR; PG8_WAIT_L(0); PG8_MMA(1, 0, At, B0); PG8_BAR; PG8_SCHED;
            PG8_STAGE(PG8_SB(0, 1), b2 + hstep, voffB);
            PG8_WAIT_V(6); PG8_BAR; PG8_MMA(1, 1, At, B1); PG8_BAR;
            PG8_LDB(B0, 1, 0); PG8_SCHED; PG8_LDA(At, 1, 0); PG8_STAGE(PG8_SA(0, 1), a2 + hstep, voffA);
            PG8_WAIT_L(8); PG8_BAR; PG8_WAIT_L(0); PG8_MMA(0, 0, At, B0); PG8_BAR; PG8_SCHED;
            PG8_LDB(B1, 1, 1); PG8_STAGE(PG8_SB(1, 0), b3, voffB);
            PG8_BAR; PG8_WAIT_L(0); PG8_MMA(0, 1, At, B1); PG8_BAR;
            PG8_LDA(At, 1, 1); PG8_STAGE(PG8_SA(1, 0), a3, voffA);
            PG8_BAR; PG8_WAIT_L(0); PG8_MMA(1, 0, At, B0); PG8_BAR; PG8_SCHED;
            PG8_STAGE(PG8_SB(1, 1), b3 + hstep, voffB);
            PG8_WAIT_V(6); PG8_BAR; PG8_MMA(1, 1, At, B1); PG8_BAR;
        }
        E(acc, cur, wr, wc, fr, fq);
        if (!has_next) break;
#pragma unroll
        for (int a = 0; a < 2; ++a)
#pragma unroll
            for (int b = 0; b < 2; ++b)
#pragma unroll
                for (int m = 0; m < 4; ++m)
#pragma unroll
                    for (int n = 0; n < 2; ++n) acc[a][b][m][n] = (f32x4){0.f, 0.f, 0.f, 0.f};
        cur = nxt; cA = nA; cB = nB; ++ui;
    }
    PG8_WAIT_V(0);
    if (wr == 0) PG8_BAR;
    PG8_BAR;
#undef PG8_SA
#undef PG8_SB
#undef PG8_STAGE
#undef PG8_LDA
#undef PG8_LDB
#undef PG8_MMA
#undef PG8_WAIT_V
#undef PG8_WAIT_L
#undef PG8_BAR
#undef PG8_SCHED
}
}

__device__ __forceinline__ void transpose_tile(const float* __restrict__ src, int ldsrc, int k0, int c0, bf16_t* __restrict__ dst, int lddst, int n0, float sc = 1.0f, const float* __restrict__ kscale = nullptr) {
    const int lane = threadIdx.x & 63;
    const float* p = src + (size_t)k0 * ldsrc + c0 + lane;
    float v[32];
#pragma unroll
    for (int k = 0; k < 32; ++k) v[k] = p[(size_t)k * ldsrc];
    if (kscale) {
#pragma unroll
        for (int k = 0; k < 32; ++k) v[k] *= kscale[k0 + k];
    }
    bf16_t* q = dst + (size_t)(n0 + lane) * lddst + k0;
#pragma unroll
    for (int c = 0; c < 4; ++c) { u32x4 w; w.x = cvt_pk_bf16(v[8 * c] * sc, v[8 * c + 1] * sc); w.y = cvt_pk_bf16(v[8 * c + 2] * sc, v[8 * c + 3] * sc);
        w.z = cvt_pk_bf16(v[8 * c + 4] * sc, v[8 * c + 5] * sc); w.w = cvt_pk_bf16(v[8 * c + 6] * sc, v[8 * c + 7] * sc);
        *(u32x4*)(q + 8 * c) = w; }
}

__device__ __forceinline__ void phase_prep(const Args& a, unsigned char* shm) {
    bf16_t* WA = (bf16_t*)(a.ws + WS_WA); bf16_t* WV = (bf16_t*)(a.ws + WS_WV); bf16_t* WO = (bf16_t*)(a.ws + WS_WO);
    bf16_t* WGU = (bf16_t*)(a.ws + WS_WGU); bf16_t* WD = (bf16_t*)(a.ws + WS_WD);
    for (int ti = blockIdx.x * 8 + (threadIdx.x >> 6); ti < 6272; ti += gridDim.x * 8) {
        if (ti < 1024) { const int nt_ = ti >> 5, kt = ti & 31; const int n0 = nt_ * 64;
            const int c0 = n0 < 1024 ? n0 : (n0 < 1536 ? n0 + 512 : n0 + 1024);
            const float sc = n0 < 512 ? 0.125f * LOG2E : ((n0 >= 1280 && n0 < 1536) ? 0.125f : 1.0f);
            transpose_tile(a.w_in, 3072, kt * 32, c0, WA, 1024, n0, sc);
        } else if (ti < 1536) { const int q = ti - 1024, nt_ = q >> 5, kt = q & 31; const int n0 = nt_ * 64;
            const int c0 = n0 < 512 ? 1024 + n0 : n0 + 1536;
            transpose_tile(a.w_in, 3072, kt * 32, c0, WV, 1024, n0);
        } else if (ti < 2048) { const int q = ti - 1536, nt_ = q >> 5, kt = q & 31;
            transpose_tile(a.w_out, 1024, kt * 32, nt_ * 64, WO, 1024, nt_ * 64);
        } else if (ti < 4864) { const int q = ti - 2048, nt_ = q >> 5, kt = q & 31; const int n0 = nt_ * 64;
            const int P = n0 >> 8, bj = (n0 >> 7) & 1, j0 = n0 & 127;
            transpose_tile(bj ? a.w_up : a.w_gate, DFF, kt * 32, P * 128 + j0, WGU, 1024, n0, 1.0f, a.pre_ffn_g);
        } else { const int q = ti - 4864, nt_ = q / 88, kt = q % 88;
            transpose_tile(a.w_down, 1024, kt * 32, nt_ * 64, WD, DFF, nt_ * 64);
        }
    }
    { u32x4* z = (u32x4*)(a.ws + WS_STAT); const u32x4 zero = {0u, 0u, 0u, 0u};
      for (size_t i = (size_t)blockIdx.x * 512 + threadIdx.x; i < STAT_BYTES / 16; i += (size_t)gridDim.x * 512) z[i] = zero; }
    bf16_t* H = (bf16_t*)(a.ws + WS_H);
    const int wv = threadIdx.x >> 6, lane = threadIdx.x & 63;
    const f32x4 g0 = *(const f32x4*)(a.pre_mix_g + 8 * lane), g1 = *(const f32x4*)(a.pre_mix_g + 8 * lane + 4);
    const f32x4 g2 = *(const f32x4*)(a.pre_mix_g + 512 + 8 * lane), g3 = *(const f32x4*)(a.pre_mix_g + 512 + 8 * lane + 4);
    constexpr int R0 = 4;
    for (int rowb = (blockIdx.x * 8 + wv) * R0; rowb < MTOK; rowb += gridDim.x * 8 * R0) {
        f32x4 xv[R0][4];
#pragma unroll
        for (int rr = 0; rr < R0; ++rr) { const float* xr = a.x + (size_t)(rowb + rr) * DM;
            xv[rr][0] = __builtin_nontemporal_load((const f32x4*)(xr + 8 * lane)); xv[rr][1] = __builtin_nontemporal_load((const f32x4*)(xr + 8 * lane + 4));
            xv[rr][2] = __builtin_nontemporal_load((const f32x4*)(xr + 512 + 8 * lane)); xv[rr][3] = __builtin_nontemporal_load((const f32x4*)(xr + 512 + 8 * lane + 4)); }
#pragma unroll
        for (int rr = 0; rr < R0; ++rr) {
            const f32x4 x0 = xv[rr][0], x1 = xv[rr][1], x2 = xv[rr][2], x3 = xv[rr][3];
            float ss = 0.f;
#pragma unroll
            for (int j = 0; j < 4; ++j) ss += x0[j] * x0[j] + x1[j] * x1[j] + x2[j] * x2[j] + x3[j] * x3[j];
            ss = wave_sum(ss);
            const float rn = __frsqrt_rn(ss * (1.0f / DM) + EPS);
            u32x4 w0, w1;
            w0.x = cvt_pk_bf16(x0[0] * rn * g0[0], x0[1] * rn * g0[1]); w0.y = cvt_pk_bf16(x0[2] * rn * g0[2], x0[3] * rn * g0[3]);
            w0.z = cvt_pk_bf16(x1[0] * rn * g1[0], x1[1] * rn * g1[1]); w0.w = cvt_pk_bf16(x1[2] * rn * g1[2], x1[3] * rn * g1[3]);
            w1.x = cvt_pk_bf16(x2[0] * rn * g2[0], x2[1] * rn * g2[1]); w1.y = cvt_pk_bf16(x2[2] * rn * g2[2], x2[3] * rn * g2[3]);
            w1.z = cvt_pk_bf16(x3[0] * rn * g3[0], x3[1] * rn * g3[1]); w1.w = cvt_pk_bf16(x3[2] * rn * g3[2], x3[3] * rn * g3[3]);
            *(u32x4*)(H + (size_t)(rowb + rr) * DM + 8 * lane) = w0; *(u32x4*)(H + (size_t)(rowb + rr) * DM + 512 + 8 * lane) = w1;
        }
    }
}

__device__ __forceinline__ void unpack8(const u32x4 w, float (&v)[8]) {
    v[0] = bf_lo(w.x); v[1] = bf_hi(w.x); v[2] = bf_lo(w.y); v[3] = bf_hi(w.y); v[4] = bf_lo(w.z); v[5] = bf_hi(w.z); v[6] = bf_lo(w.w); v[7] = bf_hi(w.w);
}

constexpr int AT_STAGE = 49152;
constexpr int AT_VOFF = 16384;

template <int TYPE>
__device__ __forceinline__ void attn_unit(const Args& a, unsigned char* lds, int b, int hsel, int qblk, float lam) {
    int tid_ = threadIdx.x; asm volatile("" : "+v"(tid_));
    const int tid = tid_, wv = tid >> 6, lane = tid & 63, r = lane & 31, hh = lane >> 5;
    const int g = wv >> 2, wq = wv & 3;
    const bf16_t* QK = (const bf16_t*)(a.ws + WS_QK); const bf16_t* VT = (const bf16_t*)(a.ws + WS_VT); bf16_t* OMIX = (bf16_t*)(a.ws + WS_OMIX);
    const int tok0 = b * SEQ, q0 = TYPE == 0 ? qblk * 128 : qblk * 256 + g * 128;
    int qcol, vrow0;
    if (TYPE == 0) { qcol = hsel * 128 + g * 64; vrow0 = hsel * 128; }
    else { qcol = 1024 + hsel * 64; vrow0 = 512 + hsel * 128; }
    const int head = hsel;
    float c2;
    if (TYPE == 0) c2 = exp2f(-2.0f * (float)(head + 1)) * LOG2E;
    else c2 = log2f(1.0f - exp2f(-5.0f - (float)head));
    float c7[8], c4[4];
#pragma unroll
    for (int k = 0; k < 8; ++k) { const float v = TYPE == 0 ? c2 * (float)k : exp2f(-c2 * (float)k); c7[k] = __uint_as_float(__builtin_amdgcn_readfirstlane(__float_as_uint(v))); }
#pragma unroll
    for (int k = 0; k < 4; ++k) { const float v = TYPE == 0 ? c2 * (float)(16 * k) : exp2f(-c2 * (float)(16 * k)); c4[k] = __uint_as_float(__builtin_amdgcn_readfirstlane(__float_as_uint(v))); }
    const int qrow = q0 + wq * 32 + r;
    const float qposf = (float)qrow;
    bf16x8 qf[4];
    { const bf16_t* qp = QK + (size_t)(tok0 + qrow) * 2048 + qcol + hh * 8;
#pragma unroll
      for (int s = 0; s < 4; ++s) qf[s] = *(const bf16x8*)(qp + 16 * s); }
    f32x16 O[4];
#pragma unroll
    for (int d = 0; d < 4; ++d)
#pragma unroll
        for (int i = 0; i < 16; ++i) O[d][i] = 0.f;
    float m_run = -1e30f, l_run = 0.f;
    const int mychunk = TYPE == 0 ? 2 * qblk + (wq >> 1) : 4 * qblk + 2 * g + (wq >> 1), nsteps = TYPE == 0 ? 2 * (qblk + 1) : 4 * (qblk + 1);
    const int rs = (r & 0x13) | ((r & 4) << 1) | ((r & 8) >> 1);
    constexpr int KT = TYPE == 0 ? 8192 : 4096, VOFF = TYPE == 0 ? AT_VOFF : 8192;
    int kx[4], vx[4];
#pragma unroll
    for (int s = 0; s < 4; ++s) { kx[s] = TYPE == 0 ? rs * 256 + ((((g * 8 + hh) ^ (rs & 15)) ^ (2 * s)) << 4) : rs * 128 + ((((2 * s) + hh) ^ ((rs >> 1) & 7)) << 4);
        vx[s] = VOFF + r * 128 + (((hh ^ ((r >> 1) & 7)) ^ (2 * s)) << 4); }
    constexpr int NV = 2, NK = TYPE == 0 ? 2 : 1, NI = NK + NV;
    const int wvu = __builtin_amdgcn_readfirstlane(wv);
    const bf16_t* K2 = (const bf16_t*)(a.ws + WS_K2);
    const bf16_t* kt0 = K2 + ((size_t)(tok0 >> 6) * 6 + (TYPE == 0 ? hsel : 4 + (hsel >> 1))) * 8192 + (TYPE == 0 ? 0 : (hsel & 1) * 64);
    const bf16_t* vt0 = VT + ((size_t)(tok0 >> 6) * VT_ROWS + vrow0) * 64;
    unsigned kgo[NK], vgo[NV];
#pragma unroll
    for (int i = 0; i < NK; ++i) { if (TYPE == 0) { const int row = (wv * 2 + i) * 4 + (lane >> 4); kgo[i] = (unsigned)(row * 128 + (((lane & 15) ^ (row & 15)) << 3)) * 2u; }
        else { const int row = wv * 8 + (lane >> 3); kgo[i] = (unsigned)(row * 128 + (((lane & 7) ^ ((row >> 1) & 7)) << 3)) * 2u; } }
#pragma unroll
    for (int i = 0; i < NV; ++i) { const int row = (wv * NV + i) * 8 + (lane >> 3); vgo[i] = (unsigned)(row * 64 + (((lane & 7) ^ ((row >> 1) & 7)) << 3)) * 2u; }
    LAS unsigned char* ldsl = (LAS unsigned char*)lds;
#define AT_GLDS(j, stoff) do { const char* _kb = (const char*)(kt0 + (size_t)(j) * (6 * 8192)); const char* _vb = (const char*)(vt0 + (size_t)(j) * (VT_ROWS * 64)); \
        _Pragma("unroll") for (int _i = 0; _i < NK; ++_i) __builtin_amdgcn_global_load_lds((const unsigned*)(_kb + kgo[_i]), (LAS unsigned*)(ldsl + (stoff) + (wvu * NK + _i) * 1024), 16, 0, 0); \
        _Pragma("unroll") for (int _i = 0; _i < NV; ++_i) __builtin_amdgcn_global_load_lds((const unsigned*)(_vb + vgo[_i]), (LAS unsigned*)(ldsl + (stoff) + VOFF + (wvu * NV + _i) * 1024), 16, 0, 0); } while (0)
#pragma unroll
    for (int s = 0; s < 4; ++s) asm volatile("" : "+v"(qf[s]));
#define AT_PV(stp, PK) do { bf16x8 _av[16]; __builtin_amdgcn_s_setprio(1); \
        _Pragma("unroll") for (int t = 0; t < 2; ++t) _Pragma("unroll") for (int s2 = 0; s2 < 2; ++s2) _Pragma("unroll") for (int d = 0; d < 4; ++d) \
            _av[(2 * t + s2) * 4 + d] = *(const bf16x8*)((stp) + vx[2 * t + s2] + d * 4096); \
        _Pragma("unroll") for (int t = 0; t < 2; ++t) _Pragma("unroll") for (int s2 = 0; s2 < 2; ++s2) _Pragma("unroll") for (int d = 0; d < 4; ++d) \
            O[d] = __builtin_amdgcn_mfma_f32_32x32x16_bf16(_av[(2 * t + s2) * 4 + d], PK[t][s2], O[d], 0, 0, 0); \
        __builtin_amdgcn_sched_group_barrier(0x100, 4, 0); \
        _Pragma("unroll") for (int _q = 0; _q < 12; ++_q) { __builtin_amdgcn_sched_group_barrier(0x008, 1, 0); __builtin_amdgcn_sched_group_barrier(0x100, 1, 0); } \
        __builtin_amdgcn_sched_group_barrier(0x008, 4, 0); __builtin_amdgcn_s_setprio(0); } while (0)
    constexpr int NST = 4, STSZ = TYPE == 0 ? 32768 : 24576;
    const bool rot = g == 1;
    bf16x8 pk[2][2];
#pragma unroll
    for (int t = 0; t < 2; ++t)
#pragma unroll
        for (int s2 = 0; s2 < 2; ++s2) pk[t][s2] = (bf16x8){0, 0, 0, 0, 0, 0, 0, 0};
    bool live_c = false; const unsigned char* st_c = lds;
    AT_GLDS(nsteps - 1, 0); AT_GLDS(nsteps - 2, STSZ);
    int st_cur = 0, st_nx = 2 * STSZ;
    for (int jj = 0; jj < nsteps; ++jj) {
        const int j = nsteps - 1 - jj;
        if (jj + 1 < nsteps) { if (NI == 4) asm volatile("s_waitcnt vmcnt(4)" ::: "memory"); else asm volatile("s_waitcnt vmcnt(3)" ::: "memory"); }
        else asm volatile("s_waitcnt vmcnt(0)" ::: "memory");
        __builtin_amdgcn_s_barrier();
        asm volatile("" ::: "memory");
        if (jj + 2 < nsteps) AT_GLDS(j - 2, st_nx);
        const unsigned char* st = lds + st_cur;
        st_cur = st_cur == (NST - 1) * STSZ ? 0 : st_cur + STSZ; st_nx = st_nx == (NST - 1) * STSZ ? 0 : st_nx + STSZ;
        if (rot && live_c) AT_PV(st_c, pk);
        bool live = false;
        if (j <= mychunk) {
            f32x16 S0, S1;
#pragma unroll
            for (int i = 0; i < 16; ++i) { S0[i] = 0.f; S1[i] = 0.f; }
            { bf16x8 ka[8]; __builtin_amdgcn_s_setprio(1);
#pragma unroll
              for (int s = 0; s < 4; ++s) { ka[2 * s] = *(const bf16x8*)(st + kx[s]); ka[2 * s + 1] = *(const bf16x8*)(st + kx[s] + KT); }
#pragma unroll
              for (int s = 0; s < 4; ++s) { S0 = __builtin_amdgcn_mfma_f32_32x32x16_bf16(ka[2 * s], qf[s], S0, 0, 0, 0);
                  S1 = __builtin_amdgcn_mfma_f32_32x32x16_bf16(ka[2 * s + 1], qf[s], S1, 0, 0, 0); }
              __builtin_amdgcn_sched_group_barrier(0x100, 4, 0);
#pragma unroll
              for (int q_ = 0; q_ < 4; ++q_) { __builtin_amdgcn_sched_group_barrier(0x008, 1, 0); __builtin_amdgcn_sched_group_barrier(0x100, 1, 0); }
              __builtin_amdgcn_sched_group_barrier(0x008, 4, 0); __builtin_amdgcn_s_setprio(0); }
            MFMA_GUARD(S0, S1);
            const float d0 = (float)(64 * j + 8 * hh) - qposf;
            float gadd[4];
            live = true;
            if (TYPE == 0) {
                if (j == mychunk) {
#pragma unroll
                    for (int i = 0; i < 16; ++i) { const float off = (float)(16 * (i >> 3) + (i & 7));
                        S0[i] -= c2 * fabsf(d0 + off); S1[i] -= c2 * fabsf(d0 + off + 32.0f); }
#pragma unroll
                    for (int k = 0; k < 4; ++k) gadd[k] = 0.f;
                } else {
#pragma unroll
                    for (int i = 0; i < 16; ++i) { S0[i] = a_adds(c7[i & 7], S0[i]); S1[i] = a_adds(c7[i & 7], S1[i]); }
                    const float base = c2 * d0;
#pragma unroll
                    for (int k = 0; k < 4; ++k) gadd[k] = base + c4[k];
                }
                float m0 = a_max3(S0[0], S0[1], S0[2]), m1 = a_max3(S0[8], S0[9], S0[10]), m2 = a_max3(S1[0], S1[1], S1[2]), m3 = a_max3(S1[8], S1[9], S1[10]);
                m0 = a_max3(m0, S0[3], S0[4]); m1 = a_max3(m1, S0[11], S0[12]); m2 = a_max3(m2, S1[3], S1[4]); m3 = a_max3(m3, S1[11], S1[12]);
                m0 = a_max3(m0, S0[5], S0[6]); m1 = a_max3(m1, S0[13], S0[14]); m2 = a_max3(m2, S1[5], S1[6]); m3 = a_max3(m3, S1[13], S1[14]);
                m0 = a_max(m0, S0[7]); m1 = a_max(m1, S0[15]); m2 = a_max(m2, S1[7]); m3 = a_max(m3, S1[15]);
                float mx = a_max3(a_add(m0, gadd[0]), a_add(m1, gadd[1]), a_max(a_add(m2, gadd[2]), a_add(m3, gadd[3])));
                mx = half_max(mx);
                if (__all(mx < m_run - 40.0f)) live = false;
                else {
                    if (!__all(mx <= m_run + 8.0f)) {
                        const float mn = fmaxf(m_run, mx); const float alpha = __builtin_amdgcn_exp2f(m_run - mn); m_run = mn; l_run *= alpha;
#pragma unroll
                        for (int d = 0; d < 4; ++d)
#pragma unroll
                            for (int i = 0; i < 16; ++i) O[d][i] *= alpha;
                    }
                    const float g0 = gadd[0] - m_run, g1 = gadd[1] - m_run, g2 = gadd[2] - m_run, g3 = gadd[3] - m_run;
                    float pa = 0.f, pb = 0.f, pc = 0.f, pd = 0.f;
#pragma unroll
                    for (int i = 0; i < 8; ++i) { S0[i] = __builtin_amdgcn_exp2f(a_add(S0[i], g0)); S0[8 + i] = __builtin_amdgcn_exp2f(a_add(S0[8 + i], g1));
                        S1[i] = __builtin_amdgcn_exp2f(a_add(S1[i], g2)); S1[8 + i] = __builtin_amdgcn_exp2f(a_add(S1[8 + i], g3));
                        pa = a_add(pa, S0[i]); pb = a_add(pb, S0[8 + i]); pc = a_add(pc, S1[i]); pd = a_add(pd, S1[8 + i]); }
                    l_run += a_add(a_add(pa, pb), a_add(pc, pd));
                }
            } else {
                if (j == mychunk) {
#pragma unroll
                    for (int i = 0; i < 16; ++i) { const float off = (float)(16 * (i >> 3) + (i & 7));
                        S0[i] *= __builtin_amdgcn_exp2f(c2 * fabsf(d0 + off)); S1[i] *= __builtin_amdgcn_exp2f(c2 * fabsf(d0 + off + 32.0f)); }
                } else {
                    const float fl = __builtin_amdgcn_exp2f(-c2 * d0);
                    const float g0 = fl * c4[0], g1 = fl * c4[1], g2 = fl * c4[2], g3 = fl * c4[3];
#pragma unroll
                    for (int i = 0; i < 8; ++i) { S0[i] = a_mul(a_muls(c7[i], S0[i]), g0); S0[8 + i] = a_mul(a_muls(c7[i], S0[8 + i]), g1); S1[i] = a_mul(a_muls(c7[i], S1[i]), g2); S1[8 + i] = a_mul(a_muls(c7[i], S1[8 + i]), g3); }
                }
            }
            if (live) {
#pragma unroll
                for (int s2 = 0; s2 < 2; ++s2) {
                    u32x4 w0, w1;
                    w0.x = cvt_pk_bf16(S0[8 * s2], S0[8 * s2 + 1]); w0.y = cvt_pk_bf16(S0[8 * s2 + 2], S0[8 * s2 + 3]); w0.z = cvt_pk_bf16(S0[8 * s2 + 4], S0[8 * s2 + 5]); w0.w = cvt_pk_bf16(S0[8 * s2 + 6], S0[8 * s2 + 7]);
                    w1.x = cvt_pk_bf16(S1[8 * s2], S1[8 * s2 + 1]); w1.y = cvt_pk_bf16(S1[8 * s2 + 2], S1[8 * s2 + 3]); w1.z = cvt_pk_bf16(S1[8 * s2 + 4], S1[8 * s2 + 5]); w1.w = cvt_pk_bf16(S1[8 * s2 + 6], S1[8 * s2 + 7]);
                    pk[0][s2] = *reinterpret_cast<bf16x8*>(&w0); pk[1][s2] = *reinterpret_cast<bf16x8*>(&w1);
                }
                if (!rot) AT_PV(st, pk);
            }
        }
        live_c = live; st_c = st;
    }
    if (rot && live_c) AT_PV(st_c, pk);
    __syncthreads();
#undef AT_GLDS
#undef AT_PV
    const size_t tokb = (size_t)(tok0 + q0 + wq * 32);
    constexpr int TPITCH = 272;
    if (TYPE == 0) {
        const float lt = half_sum(l_run);
        float* comb = (float*)lds;
        if (g == 1) { const float sc = lam / lt;
#pragma unroll
            for (int d = 0; d < 4; ++d)
#pragma unroll
                for (int i = 0; i < 16; ++i) comb[(wq * 64 + d * 16 + i) * 64 + lane] = O[d][i] * sc; }
        __syncthreads();
        if (g == 0) { const float inv = 1.0f / lt; float ss = 0.f;
#pragma unroll
            for (int d = 0; d < 4; ++d)
#pragma unroll
                for (int i = 0; i < 16; ++i) { const float v = O[d][i] * inv - comb[(wq * 64 + d * 16 + i) * 64 + lane]; O[d][i] = v; ss += v * v; }
            ss = half_sum(ss);
            const float rn = __frsqrt_rn(ss * (1.0f / 128.0f) + EPS) * 0.8f;
            unsigned char* tile = lds + 65536 + wq * (32 * TPITCH);
#pragma unroll
            for (int d = 0; d < 4; ++d)
#pragma unroll
                for (int q4 = 0; q4 < 4; ++q4) { const int dv = 32 * d + 8 * q4 + 4 * hh;
                    const f32x4 gv = *(const f32x4*)(a.subln_g + dv);
                    u32x2 w; w.x = cvt_pk_bf16(O[d][4 * q4] * rn * gv[0], O[d][4 * q4 + 1] * rn * gv[1]); w.y = cvt_pk_bf16(O[d][4 * q4 + 2] * rn * gv[2], O[d][4 * q4 + 3] * rn * gv[3]);
                    *(u32x2*)(tile + r * TPITCH + dv * 2) = w; }
            bf16_t* op = OMIX + tokb * DM + hsel * 128 + (lane & 15) * 8;
#pragma unroll
            for (int k = 0; k < 8; ++k) { const int row = 4 * k + (lane >> 4);
                const u32x4 v = *(const u32x4*)(tile + row * TPITCH + (lane & 15) * 16);
                *(u32x4*)(op + (size_t)row * DM) = v; } }
        __syncthreads();
    } else {
        float ss = 0.f;
#pragma unroll
        for (int d = 0; d < 4; ++d)
#pragma unroll
            for (int i = 0; i < 16; ++i) ss += O[d][i] * O[d][i];
        ss = half_sum(ss);
        const float rn = __frsqrt_rn(ss * (1.0f / 128.0f) + EPS);
        unsigned char* tile = lds + 49152 + wv * (32 * TPITCH);
#pragma unroll
        for (int d = 0; d < 4; ++d)
#pragma unroll
            for (int q4 = 0; q4 < 4; ++q4) { const int dv = 32 * d + 8 * q4 + 4 * hh;
                const f32x4 gv = *(const f32x4*)(a.ret_g + dv);
                u32x2 w; w.x = cvt_pk_bf16(O[d][4 * q4] * rn * gv[0], O[d][4 * q4 + 1] * rn * gv[1]); w.y = cvt_pk_bf16(O[d][4 * q4 + 2] * rn * gv[2], O[d][4 * q4 + 3] * rn * gv[3]);
                *(u32x2*)(tile + r * TPITCH + dv * 2) = w; }
        const bf16_t* gp = QK + tokb * 2048 + 1536 + head * 128 + (lane & 15) * 8;
        bf16_t* op = OMIX + tokb * DM + 512 + head * 128 + (lane & 15) * 8;
        u32x4 gw[8];
#pragma unroll
        for (int k = 0; k < 8; ++k) gw[k] = *(const u32x4*)(gp + (size_t)(4 * k + (lane >> 4)) * 2048);
#pragma unroll
        for (int k = 0; k < 8; ++k) { const int row = 4 * k + (lane >> 4);
            const u32x4 v = *(const u32x4*)(tile + row * TPITCH + (lane & 15) * 16);
            float vv[8], gg[8]; unpack8(v, vv); unpack8(gw[k], gg);
#pragma unroll
            for (int e = 0; e < 8; ++e) vv[e] *= gg[e] * __builtin_amdgcn_rcpf(1.0f + __builtin_amdgcn_exp2f(-gg[e] * LOG2E));
            u32x4 w; w.x = cvt_pk_bf16(vv[0], vv[1]); w.y = cvt_pk_bf16(vv[2], vv[3]); w.z = cvt_pk_bf16(vv[4], vv[5]); w.w = cvt_pk_bf16(vv[6], vv[7]);
            *(u32x4*)(op + (size_t)row * DM) = w; }
        __syncthreads();
    }
}

__device__ __forceinline__ void phase_mixer(const Args& a, unsigned char* lds, int segmask = 7) {
    unsigned* barw = (unsigned*)(a.ws + WS_BAR);
    bool xcc_ok = gridDim.x == 256;
    for (int j = 0; j < 16; ++j) { const unsigned c = xb_ld(&barw[XB_XCNT(j)]); xcc_ok = xcc_ok && (c == (j < 8 ? 32u : 0u)); }
    const unsigned my_rank = ((volatile LAS unsigned*)((LAS unsigned char*)lds + 3 * AT_STAGE))[2];
    const int slot_xcc = (int)(xb_xcc_id() * 32u + my_rank);

    const int lane = threadIdx.x & 63;
    const float d1 = wave_sum(a.lq1[lane] * a.lk1[lane]), d2 = wave_sum(a.lq2[lane] * a.lk2[lane]);
    const float lam = expf(d1) - expf(d2) + 0.2f;
    for (int i = blockIdx.x; i < 768; i += gridDim.x) {
        const int seg = i >> 8, w = i & 255, p = xcc_ok ? slot_xcc : (w & 7) * 32 + (w >> 3);
        if (!((segmask >> seg) & 1)) continue;
        if (seg < 2) { const int pp = seg * 256 + p, bh = pp >> 3, pi = pp & 7; const int hd = seg ? 3 - (bh & 3) : (bh & 3);
            attn_unit<0>(a, lds, bh >> 2, hd, pi, lam); attn_unit<0>(a, lds, bh >> 2, hd, 15 - pi, lam);
        } else { const int b = p >> 4, hd = (p >> 2) & 3, pi = p & 3;
            attn_unit<1>(a, lds, b, hd, pi, lam); attn_unit<1>(a, lds, b, hd, 7 - pi, lam); }
    }
}

__global__ void __launch_bounds__(512, 2) fwd_mega(Args a, int ph_lo, int ph_hi) {
    extern __shared__ __attribute__((aligned(16))) unsigned char shm[];
    cg::grid_group grid = cg::this_grid();
    bf16_t* WA = (bf16_t*)(a.ws + WS_WA); bf16_t* WV = (bf16_t*)(a.ws + WS_WV); bf16_t* WO = (bf16_t*)(a.ws + WS_WO);
    bf16_t* WGU = (bf16_t*)(a.ws + WS_WGU); bf16_t* WD = (bf16_t*)(a.ws + WS_WD); bf16_t* H = (bf16_t*)(a.ws + WS_H);
    bf16_t* QK = (bf16_t*)(a.ws + WS_QK); bf16_t* VT = (bf16_t*)(a.ws + WS_VT); bf16_t* OMIX = (bf16_t*)(a.ws + WS_OMIX);
    bf16_t* MIXB = (bf16_t*)(a.ws + WS_MIXB); bf16_t* F = (bf16_t*)(a.ws + WS_F);
    LAS unsigned char* lds = (LAS unsigned char*)shm;
    volatile LAS unsigned* xbw = (volatile LAS unsigned*)(lds + 3 * AT_STAGE);
    if (threadIdx.x == 0) { xbw[0] = 0u; xbw[1] = 0u; xbw[2] = 0u; xbw[3] = 0u; }
    __syncthreads();
    const XcdBarrier xb = xcd_barrier_post((unsigned*)(a.ws + WS_BAR), xbw);
    if (threadIdx.x == 0) xbw[2] = xb_add(&xb.bar[XB_TKT(xb.x)], 1u);
    if (ph_hi > 1000) grid.sync();
#ifndef PHMASK
#define PHMASK 255
#endif
#ifndef DUP
#define DUP 0
#endif
#define PH_ON(k) (ph_lo <= (k) && (k) < ph_hi)
#define PH_SYNC(k) do { if (ph_lo < (k) && (k) < ph_hi) xcd_barrier(xb); } while (0)
    if ((PHMASK & 1) && PH_ON(0)) phase_prep(a, shm);
    if (DUP & 1) { xcd_barrier(xb); phase_prep(a, shm); }
    PH_SYNC(1);
    if ((PHMASK & 2) && PH_ON(1)) {
        { pg8::StaticOrder S; S.init(MTOK, 2048, (int)gridDim.x, (int)blockIdx.x);
          pg8::gemm_phase(lds, pg8::Gemm{H, WA, MTOK, 2048, DM}, S, pg8::EpiQK{QK, (bf16_t*)(a.ws + WS_K2)}); }
        { pg8::StaticOrder S2; S2.init(1024, MTOK, (int)gridDim.x, (int)blockIdx.x);
          pg8::gemm_phase(lds, pg8::Gemm{WV, H, 1024, MTOK, DM}, S2, pg8::EpiVT{VT}); }
    }
    if (DUP & 2) { xcd_barrier(xb);
        { pg8::StaticOrder S; S.init(MTOK, 2048, (int)gridDim.x, (int)blockIdx.x);
          pg8::gemm_phase(lds, pg8::Gemm{H, WA, MTOK, 2048, DM}, S, pg8::EpiQK{QK, (bf16_t*)(a.ws + WS_K2)}); }
        { pg8::StaticOrder S2; S2.init(1024, MTOK, (int)gridDim.x, (int)blockIdx.x);
          pg8::gemm_phase(lds, pg8::Gemm{WV, H, 1024, MTOK, DM}, S2, pg8::EpiVT{VT}); } }
    PH_SYNC(2);
    if ((PHMASK & 4) && PH_ON(2)) phase_mixer(a, shm);
    if (DUP & 4) { xcd_barrier(xb); phase_mixer(a, shm); }
    if (DUP & 256) { xcd_barrier(xb); phase_mixer(a, shm, 3); }
    if (DUP & 512) { xcd_barrier(xb); phase_mixer(a, shm, 4); }
    PH_SYNC(3);
    if ((PHMASK & 8) && PH_ON(3)) {
        pg8::StaticOrder S; S.init(MTOK, DM, (int)gridDim.x, (int)blockIdx.x);
        unsigned long long* ss = (unsigned long long*)(a.ws + WS_STAT); unsigned* cn = (unsigned*)(a.ws + WS_STAT + STAT_CNT_OFF);
        pg8::gemm_phase(lds, pg8::Gemm{OMIX, WO, MTOK, DM, DM}, S, pg8::EpiNormResNorm{a.x, MIXB, a.post_mix_g, ss, ss + MTOK, cn});
    }
    PH_SYNC(5);
    if ((PHMASK & 32) && PH_ON(5)) {
        pg8::StaticOrder S; S.init(MTOK, 2 * DFF, (int)gridDim.x, (int)blockIdx.x);
        pg8::gemm_phase(lds, pg8::Gemm{MIXB, WGU, MTOK, 2 * DFF, DM}, S, pg8::EpiSwiGLU{F, DFF, (unsigned long long*)(a.ws + WS_STAT) + MTOK});
    }
    if (DUP & 32) { xcd_barrier(xb);
        pg8::StaticOrder S; S.init(MTOK, 2 * DFF, (int)gridDim.x, (int)blockIdx.x);
        pg8::gemm_phase(lds, pg8::Gemm{MIXB, WGU, MTOK, 2 * DFF, DM}, S, pg8::EpiSwiGLU{F, DFF, (unsigned long long*)(a.ws + WS_STAT) + MTOK}); }
    PH_SYNC(6);
    if ((PHMASK & 64) && PH_ON(6)) {
        pg8::StaticOrder S; S.init(MTOK, DM, (int)gridDim.x, (int)blockIdx.x);
        pg8::gemm_phase(lds, pg8::Gemm{F, WD, MTOK, DM, DFF}, S, pg8::EpiNormRes{a.out, MIXB, a.post_ffn_g, (unsigned long long*)(a.ws + WS_STAT) + 2 * (size_t)MTOK, (unsigned*)(a.ws + WS_STAT + STAT_CNT_OFF) + 2 * 256 * 64});
    }
}

constexpr int LDS_BYTES = 3 * AT_STAGE + 16;

extern "C" void kernel_launch(void* const* d_in, const int* in_sizes, int n_in, void* d_out, int out_size, void* d_ws, size_t ws_size, hipStream_t stream) {
    static int grid_blocks = 0;
    if (!grid_blocks) {
        int dev = 0, cus = 0, per_cu = 0;
        hipGetDevice(&dev);
        hipDeviceGetAttribute(&cus, hipDeviceAttributeMultiprocessorCount, dev);
        if (hipFuncSetAttribute((const void*)fwd_mega, hipFuncAttributeMaxDynamicSharedMemorySize, LDS_BYTES) != hipSuccess) fprintf(stderr, "hipFuncSetAttribute failed\n");
        if (hipOccupancyMaxActiveBlocksPerMultiprocessor(&per_cu, (const void*)fwd_mega, 512, LDS_BYTES) != hipSuccess || per_cu < 1) { fprintf(stderr, "occupancy query: %d\n", per_cu); per_cu = 1; }
        (void)hipGetLastError();
        grid_blocks = cus * 1;
        if (ws_size < WS_END) fprintf(stderr, "workspace too small: %zu < %zu\n", ws_size, (size_t)WS_END);
    }
    if (hipMemsetAsync((char*)d_ws + WS_BAR, 0, 32768, stream) != hipSuccess) fprintf(stderr, "memset of the barrier words failed\n");
    Args a{};
    a.x = (const float*)d_in[0]; a.pre_mix_g = (const float*)d_in[1]; a.w_in = (const float*)d_in[2];
    a.lq1 = (const float*)d_in[3]; a.lk1 = (const float*)d_in[4]; a.lq2 = (const float*)d_in[5]; a.lk2 = (const float*)d_in[6];
    a.subln_g = (const float*)d_in[7]; a.ret_g = (const float*)d_in[8]; a.w_out = (const float*)d_in[9];
    a.post_mix_g = (const float*)d_in[10]; a.pre_ffn_g = (const float*)d_in[11];
    a.w_gate = (const float*)d_in[12]; a.w_up = (const float*)d_in[13]; a.w_down = (const float*)d_in[14]; a.post_ffn_g = (const float*)d_in[15];
    a.out = (float*)d_out; a.ws = (unsigned char*)d_ws;
    int ph_lo = 0, ph_hi = 8;
    void* args[] = {&a, &ph_lo, &ph_hi};
    hipError_t e = hipLaunchCooperativeKernel((const void*)fwd_mega, dim3(grid_blocks), dim3(512), args, LDS_BYTES, stream);
    if (e != hipSuccess) fprintf(stderr, "cooperative launch failed: %s (grid %d)\n", hipGetErrorString(e), grid_blocks);
}
```

```cpp
#include <hip/hip_runtime.h>
#include <hip/hip_cooperative_groups.h>
#include <cstdio>
namespace cg = cooperative_groups;

#define LAS __attribute__((address_space(3)))
typedef unsigned short bf16_t;
typedef short bf16x8 __attribute__((ext_vector_type(8)));
typedef float f32x4 __attribute__((ext_vector_type(4)));
typedef float f32x16 __attribute__((ext_vector_type(16)));
typedef unsigned u32x4 __attribute__((ext_vector_type(4)));
typedef unsigned u32x2 __attribute__((ext_vector_type(2)));

constexpr int MTOK = 32768, DM = 1024, SEQ = 2048, DFF = 2816;
constexpr float EPS = 1e-6f;
constexpr float LOG2E = 1.4426950408889634f;

constexpr size_t MiB = 1024 * 1024;
constexpr size_t WS_WA = 0;
constexpr size_t WS_WV = WS_WA + 4 * MiB;
constexpr size_t WS_WO = WS_WV + 2 * MiB;
constexpr size_t WS_WGU = WS_WO + 2 * MiB;
constexpr size_t WS_WD = WS_WGU + 11 * MiB;
constexpr size_t WS_H = WS_WD + 6 * MiB;
constexpr size_t WS_QK = WS_H + 64 * MiB;
constexpr size_t WS_VT = WS_QK + 128 * MiB;
constexpr int VT_ROWS = 1040;
constexpr size_t WS_OMIX = WS_VT + 72 * MiB;
constexpr size_t WS_MIXB = WS_OMIX + 64 * MiB;
constexpr size_t WS_F = WS_QK;
constexpr size_t WS_K2 = WS_MIXB + 64 * MiB;
constexpr size_t WS_BAR = WS_K2 + 48 * MiB;
constexpr size_t WS_STAT = WS_BAR + 32768;
constexpr size_t STAT_SS_BYTES = (size_t)MTOK * 8, STAT_CNT_OFF = 3 * STAT_SS_BYTES, STAT_BYTES = STAT_CNT_OFF + 3 * 256 * 256;
constexpr size_t WS_END = WS_STAT + STAT_BYTES;

struct Args {
    const float* x; const float* pre_mix_g; const float* w_in; const float* lq1; const float* lk1; const float* lq2; const float* lk2;
    const float* subln_g; const float* ret_g; const float* w_out; const float* post_mix_g; const float* pre_ffn_g;
    const float* w_gate; const float* w_up; const float* w_down; const float* post_ffn_g;
    float* out; unsigned char* ws;
};

__device__ __forceinline__ unsigned cvt_pk_bf16(float lo, float hi) { unsigned r; asm("v_cvt_pk_bf16_f32 %0, %1, %2" : "=v"(r) : "v"(lo), "v"(hi)); return r; }
__device__ __forceinline__ float bf_lo(unsigned w) { return __uint_as_float(w << 16); }
__device__ __forceinline__ float bf_hi(unsigned w) { return __uint_as_float(w & 0xffff0000u); }
__device__ __forceinline__ float a_add(float a, float b)  { float r; asm("v_add_f32_e32 %0, %1, %2" : "=v"(r) : "v"(a), "v"(b)); return r; }
__device__ __forceinline__ float a_adds(float s_, float b) { float r; asm("v_add_f32_e32 %0, %1, %2" : "=v"(r) : "s"(s_), "v"(b)); return r; }
__device__ __forceinline__ float a_mul(float a, float b)  { float r; asm("v_mul_f32_e32 %0, %1, %2" : "=v"(r) : "v"(a), "v"(b)); return r; }
__device__ __forceinline__ float a_muls(float s_, float b) { float r; asm("v_mul_f32_e32 %0, %1, %2" : "=v"(r) : "s"(s_), "v"(b)); return r; }
__device__ __forceinline__ float a_max(float a, float b)  { float r; asm("v_max_f32_e32 %0, %1, %2" : "=v"(r) : "v"(a), "v"(b)); return r; }
__device__ __forceinline__ float a_max3(float a, float b, float c) { float r; asm("v_max3_f32 %0, %1, %2, %3" : "=v"(r) : "v"(a), "v"(b), "v"(c)); return r; }
#define MFMA_GUARD(X, Y) asm volatile("s_nop 15\n\ts_nop 3" : "+v"(X), "+v"(Y))
__device__ __forceinline__ float half_sum(float v) { auto rr = __builtin_amdgcn_permlane32_swap(__float_as_uint(v), __float_as_uint(v), false, false); return __uint_as_float(rr[0]) + __uint_as_float(rr[1]); }
__device__ __forceinline__ float half_max(float v) { auto rr = __builtin_amdgcn_permlane32_swap(__float_as_uint(v), __float_as_uint(v), false, false); return fmaxf(__uint_as_float(rr[0]), __uint_as_float(rr[1])); }
__device__ __forceinline__ float wave_sum(float v) {
#pragma unroll
    for (int o = 32; o > 0; o >>= 1) v += __shfl_xor(v, o);
    return v;
}

#define XB_TMO      128
#define XB_XCNT(j)  (256  + 64 * (j))
#define XB_XSUB(j)  (1280 + 64 * (j))
#define XB_XGEN(j)  (2304 + 64 * (j))
#define XB_TOP      3328
#define XB_TOPGEN   3392
#define XCD_BAR_WORDS 3456
#define XB_TKT(j)   (3456 + 64 * (j))
#define XB_ALL_WORDS (3456 + 16 * 64)
#define XB_SPIN_CAP (1u << 18)
__device__ __forceinline__ unsigned xb_ld(unsigned* p)              { return __hip_atomic_load(p, __ATOMIC_RELAXED, __HIP_MEMORY_SCOPE_AGENT); }
__device__ __forceinline__ unsigned xb_add(unsigned* p, unsigned v) { return __hip_atomic_fetch_add(p, v, __ATOMIC_RELAXED, __HIP_MEMORY_SCOPE_AGENT); }
__device__ __forceinline__ unsigned xb_xcc_id() { return (unsigned)__builtin_amdgcn_s_getreg((3 << 11) | 20) & 0xFu; }
#define XB_SPIN(cond, bar) do { unsigned _sp = 0; while (cond) { __builtin_amdgcn_s_sleep(1); \
    if ((++_sp & 255u) == 0u) { if (xb_ld(&(bar)[XB_TMO])) break; if (_sp > XB_SPIN_CAP) { atomicAdd(&(bar)[XB_TMO], 1u); break; } } } } while (0)
struct XcdBarrier { unsigned* bar; unsigned x; volatile LAS unsigned* st; };
__device__ __forceinline__ XcdBarrier xcd_barrier_post(unsigned* bar, volatile LAS unsigned* st) {
    XcdBarrier b; b.bar = bar; b.x = xb_xcc_id(); b.st = st;
    if (threadIdx.x == 0) (void)xb_add(&bar[XB_XCNT(b.x)], 1u);
    return b;
}
__device__ __forceinline__ void xcd_barrier_complete(unsigned* bar, unsigned x, unsigned& nloc, unsigned& nx) {
    const unsigned G = gridDim.x * gridDim.y * gridDim.z;
    unsigned sum, cnt, mine, sp = 0u;
    for (;;) {
        sum = 0u; cnt = 0u; mine = 0u;
#pragma unroll
        for (unsigned j = 0; j < 16; ++j) { const unsigned c = xb_ld(&bar[XB_XCNT(j)]); sum += c; cnt += (c > 0u) ? 1u : 0u; mine = (j == x) ? c : mine; }
        if (sum == G) break;
        __builtin_amdgcn_s_sleep(1);
        if ((++sp & 255u) == 0u) { if (xb_ld(&bar[XB_TMO])) break; if (sp > XB_SPIN_CAP) { atomicAdd(&bar[XB_TMO], 1u); break; } }
    }
    nloc = mine > 0u ? mine : 1u; nx = cnt > 0u ? cnt : 1u;
}
__device__ __forceinline__ void xcd_barrier(const XcdBarrier& b) {
    asm volatile("s_waitcnt vmcnt(0)" ::: "memory");
    __syncthreads();
    if (threadIdx.x == 0) {
        unsigned* bar = b.bar;
        __builtin_amdgcn_s_waitcnt(0);
        unsigned nloc = b.st[0], nx = b.st[1];
        if (nloc == 0u) { xcd_barrier_complete(bar, b.x, nloc, nx); b.st[0] = nloc; b.st[1] = nx; }
        const unsigned old = xb_add(&bar[XB_XSUB(b.x)], 1u);
        const unsigned gen = old / nloc;
        if (old + 1u == (gen + 1u) * nloc) {
            __builtin_amdgcn_fence(__ATOMIC_RELEASE, "agent");
            asm volatile("s_waitcnt vmcnt(0)" ::: "memory");
            const unsigned og = xb_add(&bar[XB_TOP], 1u);
            const unsigned tg = og / nx;
            if (og + 1u == (tg + 1u) * nx) xb_add(&bar[XB_TOPGEN], 1u);
            else XB_SPIN(xb_ld(&bar[XB_TOPGEN]) == tg, bar);
            __builtin_amdgcn_fence(__ATOMIC_ACQUIRE, "agent");
            xb_add(&bar[XB_XGEN(b.x)], 1u);
            asm volatile("s_waitcnt vmcnt(0)" ::: "memory");
        } else {
            XB_SPIN(xb_ld(&bar[XB_XGEN(b.x)]) == gen, bar);
            __builtin_amdgcn_fence(__ATOMIC_ACQUIRE, "agent");
            asm volatile("s_waitcnt vmcnt(0)" ::: "memory");
        }
    }
    __syncthreads();
}

namespace pg8 {
constexpr int BM = 256, BK = 64, HALF = 128, HTB = HALF * BK * 2, STAGE_BYTES = 8 * HTB, NXCD = 8, WGM = 8;
__host__ __device__ __forceinline__ int lds_byte(int r, int c) { const int st = (r >> 4) * 2 + (c >> 5), rr = r & 15, cc = c & 31, ob = rr * 64 + cc * 2; return st * 1024 + (ob ^ (((ob >> 9) & 1) << 5)); }
__host__ __device__ __forceinline__ void stage_rc(int b, int& R, int& C) { const int st = b / 1024, sb = b % 1024, swz = sb ^ (((sb >> 9) & 1) << 5); R = (st >> 1) * 16 + swz / 64; C = (st & 1) * 32 + (swz % 64) / 2; }
__host__ __device__ __forceinline__ int perm32(int rho) { const int n = rho >> 4, i = rho & 15; return 8 * (i >> 2) + 4 * n + (i & 3); }
struct Unit { int pm, pn; };
struct Gemm { const bf16_t* A; const bf16_t* Bt; int M, N, K; };
struct StaticOrder {
    int nM, nN, nwg, G, c;
    __host__ __device__ void init(int M, int N, int G_, int c_) { nM = M / BM; nN = N / BM; nwg = nM * nN; G = G_; c = c_; }
    __host__ __device__ bool next(int i, Unit& u) const {
        const long L = (long)i * G + c; if (L >= nwg) return false;
        int wgid = (int)L; { const int q = nwg / NXCD, r = nwg % NXCD, xcd = wgid % NXCD, off = wgid / NXCD; wgid = (xcd < r ? xcd * (q + 1) : r * (q + 1) + (xcd - r) * q) + off; }
        const int nig = WGM * nN, gid = wgid / nig, fm = gid * WGM, gsz = (nM - fm) < WGM ? (nM - fm) : WGM;
        u.pm = fm + ((wgid % nig) % gsz); u.pn = (wgid % nig) / gsz; return true;
    }
};

struct EpiBf16 {
    bf16_t* O; int ldc;
    __device__ __forceinline__ void operator()(const f32x4 (&acc)[2][2][4][2], const Unit& u, int wr, int wc, int fr, int fq) const {
        const int row0 = u.pm * BM + wr * 64 + fr; const int col0 = u.pn * BM + wc * 32 + 8 * fq;
#pragma unroll
        for (int ai = 0; ai < 2; ++ai)
#pragma unroll
            for (int m = 0; m < 4; ++m) { bf16_t* rowp = O + (size_t)(row0 + ai * HALF + m * 16) * ldc + col0;
#pragma unroll
                for (int bj = 0; bj < 2; ++bj) { const f32x4 v0 = acc[ai][bj][m][0], v1 = acc[ai][bj][m][1];
                    u32x4 w; w.x = cvt_pk_bf16(v0[0], v0[1]); w.y = cvt_pk_bf16(v0[2], v0[3]); w.z = cvt_pk_bf16(v1[0], v1[1]); w.w = cvt_pk_bf16(v1[2], v1[3]);
                    *(u32x4*)(rowp + bj * HALF) = w; } }
    }
};
struct EpiQK {
    bf16_t* O; bf16_t* K2;
    __device__ __forceinline__ void operator()(const f32x4 (&acc)[2][2][4][2], const Unit& u, int wr, int wc, int fr, int fq) const {
        const int row0 = u.pm * BM + wr * 64 + fr;
        const bool isk = (u.pn == 2) || (u.pn == 3) || (u.pn == 5);
        const int slot0 = u.pn == 5 ? 4 : (u.pn - 2) * 2;
#pragma unroll
        for (int ai = 0; ai < 2; ++ai)
#pragma unroll
            for (int m = 0; m < 4; ++m) { const int row = row0 + ai * HALF + m * 16;
#pragma unroll
                for (int bj = 0; bj < 2; ++bj) { const f32x4 v0 = acc[ai][bj][m][0], v1 = acc[ai][bj][m][1];
                    u32x4 w; w.x = cvt_pk_bf16(v0[0], v0[1]); w.y = cvt_pk_bf16(v0[2], v0[3]); w.z = cvt_pk_bf16(v1[0], v1[1]); w.w = cvt_pk_bf16(v1[2], v1[3]);
                    bf16_t* p = isk ? K2 + ((size_t)((row >> 6) * 6 + slot0 + bj) * 64 + (row & 63)) * 128 + wc * 32 + 8 * fq
                                    : O + (size_t)row * 2048 + u.pn * BM + bj * HALF + wc * 32 + 8 * fq;
                    *(u32x4*)p = w; } }
    }
};
struct EpiVT {
    bf16_t* V2;
    __device__ __forceinline__ void operator()(const f32x4 (&acc)[2][2][4][2], const Unit& u, int wr, int wc, int fr, int fq) const {
        const int row0 = u.pm * BM + wr * 64 + fr;
#pragma unroll
        for (int ai = 0; ai < 2; ++ai)
#pragma unroll
            for (int m = 0; m < 4; ++m) { const int row = row0 + ai * HALF + m * 16;
#pragma unroll
                for (int bj = 0; bj < 2; ++bj) { const f32x4 v0 = acc[ai][bj][m][0], v1 = acc[ai][bj][m][1];
                    u32x4 w; w.x = cvt_pk_bf16(v0[0], v0[1]); w.y = cvt_pk_bf16(v0[2], v0[3]); w.z = cvt_pk_bf16(v1[0], v1[1]); w.w = cvt_pk_bf16(v1[2], v1[3]);
                    const int T = u.pn * 4 + bj * 2 + (wc >> 1);
                    *(u32x4*)(V2 + ((size_t)T * VT_ROWS + row) * 64 + (wc & 1) * 32 + 8 * fq) = w; } }
    }
};
constexpr float SS_SCALE = 16777216.0f, SS_INV = 1.0f / 16777216.0f;
__device__ __forceinline__ void row_ss_publish(const float (&ps)[2][4], unsigned long long* rowss, unsigned* cnt, int row0, int fq, int lane) {
    if (fq == 0) {
#pragma unroll
        for (int ai = 0; ai < 2; ++ai)
#pragma unroll
            for (int m = 0; m < 4; ++m) (void)__hip_atomic_fetch_add(rowss + row0 + ai * HALF + m * 16, (unsigned long long)(ps[ai][m] * SS_SCALE), __ATOMIC_RELAXED, __HIP_MEMORY_SCOPE_AGENT);
    }
    asm volatile("s_waitcnt vmcnt(0)" ::: "memory");
    if (lane == 0) (void)__hip_atomic_fetch_add(cnt, 1u, __ATOMIC_RELAXED, __HIP_MEMORY_SCOPE_AGENT);
    unsigned spins = 0;
    while (__hip_atomic_load(cnt, __ATOMIC_RELAXED, __HIP_MEMORY_SCOPE_AGENT) < 16u) { __builtin_amdgcn_s_sleep(2); if (++spins > (1u << 22)) break; }
    asm volatile("" ::: "memory");
}
__device__ __forceinline__ void row_rn_fetch(float (&rn)[2][4], unsigned long long* rowss, int row0) {
#pragma unroll
    for (int ai = 0; ai < 2; ++ai)
#pragma unroll
        for (int m = 0; m < 4; ++m) { const unsigned long long t = __hip_atomic_load(rowss + row0 + ai * HALF + m * 16, __ATOMIC_RELAXED, __HIP_MEMORY_SCOPE_AGENT);
            rn[ai][m] = __frsqrt_rn((float)t * SS_INV * (1.0f / 1024.0f) + EPS); }
}
struct EpiNormRes {
    float* out; const bf16_t* X1B; const float* g; unsigned long long* rowss; unsigned* cnt;
    __device__ __forceinline__ void operator()(f32x4 (&acc)[2][2][4][2], const Unit& u, int wr, int wc, int fr, int fq) const {
        const int row0 = u.pm * BM + wr * 64 + fr, col0 = u.pn * BM + wc * 32 + 8 * fq, lane = fq * 16 + fr;
        float ps[2][4], rn[2][4];
#pragma unroll
        for (int ai = 0; ai < 2; ++ai)
#pragma unroll
            for (int m = 0; m < 4; ++m) { float t = 0.f;
#pragma unroll
                for (int bj = 0; bj < 2; ++bj)
#pragma unroll
                    for (int n = 0; n < 2; ++n)
#pragma unroll
                        for (int e = 0; e < 4; ++e) t += acc[ai][bj][m][n][e] * acc[ai][bj][m][n][e];
                t += __shfl_xor(t, 16); t += __shfl_xor(t, 32); ps[ai][m] = t; }
        u32x4 xpre[2][4][2];
#pragma unroll
        for (int ai = 0; ai < 2; ++ai)
#pragma unroll
            for (int m = 0; m < 4; ++m)
#pragma unroll
                for (int bj = 0; bj < 2; ++bj) xpre[ai][m][bj] = *(const u32x4*)(X1B + (size_t)(row0 + ai * HALF + m * 16) * 1024 + col0 + bj * HALF);
        row_ss_publish(ps, rowss, cnt + (u.pm * 2 + wr) * 64, row0, fq, lane);
        row_rn_fetch(rn, rowss, row0);
#pragma unroll
        for (int ai = 0; ai < 2; ++ai)
#pragma unroll
            for (int m = 0; m < 4; ++m) { float* rowp = out + (size_t)(row0 + ai * HALF + m * 16) * 1024 + col0;
#pragma unroll
                for (int bj = 0; bj < 2; ++bj) { float* p = rowp + bj * HALF; const float* gp = g + col0 + bj * HALF;
                    const f32x4 g0 = *(const f32x4*)gp, g1 = *(const f32x4*)(gp + 4);
                    const u32x4 xw = xpre[ai][m][bj];
                    f32x4 x0 = (f32x4){bf_lo(xw.x), bf_hi(xw.x), bf_lo(xw.y), bf_hi(xw.y)}, x1 = (f32x4){bf_lo(xw.z), bf_hi(xw.z), bf_lo(xw.w), bf_hi(xw.w)};
                    x0 += acc[ai][bj][m][0] * rn[ai][m] * g0; x1 += acc[ai][bj][m][1] * rn[ai][m] * g1;
                    __builtin_nontemporal_store(x0, (f32x4*)p); __builtin_nontemporal_store(x1, (f32x4*)(p + 4)); } }
    }
};
struct EpiNormResNorm {
    const float* x; bf16_t* X1B; const float* g1; unsigned long long* rowss1; unsigned long long* rowss2; unsigned* cnt1;
    __device__ __forceinline__ void operator()(f32x4 (&acc)[2][2][4][2], const Unit& u, int wr, int wc, int fr, int fq) const {
        const int row0 = u.pm * BM + wr * 64 + fr, col0 = u.pn * BM + wc * 32 + 8 * fq, lane = fq * 16 + fr;
        float ps[2][4], rn[2][4];
#pragma unroll
        for (int ai = 0; ai < 2; ++ai)
#pragma unroll
            for (int m = 0; m < 4; ++m) { float t = 0.f;
#pragma unroll
                for (int bj = 0; bj < 2; ++bj)
#pragma unroll
                    for (int n = 0; n < 2; ++n)
#pragma unroll
                        for (int e = 0; e < 4; ++e) t += acc[ai][bj][m][n][e] * acc[ai][bj][m][n][e];
                t += __shfl_xor(t, 16); t += __shfl_xor(t, 32); ps[ai][m] = t; }
        row_ss_publish(ps, rowss1, cnt1 + (u.pm * 2 + wr) * 64, row0, fq, lane);
        row_rn_fetch(rn, rowss1, row0);
#pragma unroll
        for (int ai = 0; ai < 2; ++ai)
#pragma unroll
            for (int m = 0; m < 4; ++m) { const float* xrow = x + (size_t)(row0 + ai * HALF + m * 16) * 1024 + col0; float t = 0.f;
#pragma unroll
                for (int bj = 0; bj < 2; ++bj) { const float* gp = g1 + col0 + bj * HALF;
                    const f32x4 g0 = *(const f32x4*)gp, g1v = *(const f32x4*)(gp + 4);
                    const f32x4 x0 = __builtin_nontemporal_load((const f32x4*)(xrow + bj * HALF)), x1 = __builtin_nontemporal_load((const f32x4*)(xrow + bj * HALF + 4));
                    const f32x4 v0 = x0 + acc[ai][bj][m][0] * rn[ai][m] * g0, v1 = x1 + acc[ai][bj][m][1] * rn[ai][m] * g1v;
                    acc[ai][bj][m][0] = v0; acc[ai][bj][m][1] = v1;
#pragma unroll
                    for (int e = 0; e < 4; ++e) t += v0[e] * v0[e] + v1[e] * v1[e]; }
                t += __shfl_xor(t, 16); t += __shfl_xor(t, 32); ps[ai][m] = t; }
        if (fq == 0) {
#pragma unroll
            for (int ai = 0; ai < 2; ++ai)
#pragma unroll
                for (int m = 0; m < 4; ++m) (void)__hip_atomic_fetch_add(rowss2 + row0 + ai * HALF + m * 16, (unsigned long long)(ps[ai][m] * SS_SCALE), __ATOMIC_RELAXED, __HIP_MEMORY_SCOPE_AGENT);
        }
#pragma unroll
        for (int ai = 0; ai < 2; ++ai)
#pragma unroll
            for (int m = 0; m < 4; ++m) { const size_t ro = (size_t)(row0 + ai * HALF + m * 16) * 1024 + col0;
#pragma unroll
                for (int bj = 0; bj < 2; ++bj) { const f32x4 v0 = acc[ai][bj][m][0], v1 = acc[ai][bj][m][1];
                    u32x4 wx; wx.x = cvt_pk_bf16(v0[0], v0[1]); wx.y = cvt_pk_bf16(v0[2], v0[3]); wx.z = cvt_pk_bf16(v1[0], v1[1]); wx.w = cvt_pk_bf16(v1[2], v1[3]);
                    *(u32x4*)(X1B + ro + bj * HALF) = wx; } }
    }
};
__device__ __forceinline__ float silu_mul(float g, float u) { return g * u * __builtin_amdgcn_rcpf(1.0f + __builtin_amdgcn_exp2f(-g * LOG2E)); }
struct EpiSwiGLU {
    bf16_t* F; int ldf; const unsigned long long* rowss;
    __device__ __forceinline__ void operator()(const f32x4 (&acc)[2][2][4][2], const Unit& u, int wr, int wc, int fr, int fq) const {
        const int row0 = u.pm * BM + wr * 64 + fr; const int col0 = u.pn * HALF + wc * 32 + 8 * fq;
        float rn[2][4];
#pragma unroll
        for (int ai = 0; ai < 2; ++ai)
#pragma unroll
            for (int m = 0; m < 4; ++m) rn[ai][m] = __frsqrt_rn((float)rowss[row0 + ai * HALF + m * 16] * SS_INV * (1.0f / 1024.0f) + EPS);
#pragma unroll
        for (int ai = 0; ai < 2; ++ai)
#pragma unroll
            for (int m = 0; m < 4; ++m) { bf16_t* rowp = F + (size_t)(row0 + ai * HALF + m * 16) * ldf + col0; const float r = rn[ai][m];
                const f32x4 g0 = acc[ai][0][m][0] * r, g1 = acc[ai][0][m][1] * r, u0 = acc[ai][1][m][0] * r, u1 = acc[ai][1][m][1] * r;
                u32x4 w; w.x = cvt_pk_bf16(silu_mul(g0[0], u0[0]), silu_mul(g0[1], u0[1])); w.y = cvt_pk_bf16(silu_mul(g0[2], u0[2]), silu_mul(g0[3], u0[3]));
                w.z = cvt_pk_bf16(silu_mul(g1[0], u1[0]), silu_mul(g1[1], u1[1])); w.w = cvt_pk_bf16(silu_mul(g1[2], u1[2]), silu_mul(g1[3], u1[3]));
                *(u32x4*)rowp = w; }
    }
};

template <class Epi>
__device__ __forceinline__ void gemm_phase(LAS unsigned char* lds, const Gemm g, const StaticOrder& S, const Epi& E) {
    int tid_ = threadIdx.x; asm volatile("" : "+v"(tid_));
    const int tid = tid_, wid = __builtin_amdgcn_readfirstlane(tid >> 6), lane = tid & 63, wr = wid >> 2, wc = wid & 3, fr = lane & 15, fq = lane >> 4;
    const int K = g.K, nt = K / BK;
    unsigned voffA[2], voffB[2];
#pragma unroll
    for (int i = 0; i < 2; ++i) { int R, C; stage_rc(tid * 16 + i * 8192, R, C); const int Rb = (R & ~31) + perm32(R & 31);
        voffA[i] = (unsigned)(R * K + C) * 2u; voffB[i] = (unsigned)(Rb * K + C) * 2u; }
    const size_t kstep = (size_t)(BK * 2);
    const size_t hstep = (size_t)HALF * K * 2;
    const size_t tstep = 2 * hstep;
    const unsigned ldsw = (unsigned)wid * 1024u;
    const int aoff = lds_byte(wr * 64 + fr, fq * 8), boff = lds_byte(wc * 32 + fr, fq * 8);
#define PG8_SA(b, h) (((b) * 2 + (h)) * HTB)
#define PG8_SB(b, h) ((4 + (b) * 2 + (h)) * HTB)
#define PG8_STAGE(bufoff, gbase, voff) do { _Pragma("unroll") for (int _i = 0; _i < 2; ++_i) \
        __builtin_amdgcn_global_load_lds((const unsigned*)((const char*)(gbase) + (voff)[_i]), (LAS unsigned*)(lds + (bufoff) + ldsw + _i * 8192), 16, 0, 0); } while (0)
#define PG8_LDA(dst, b, h) do { _Pragma("unroll") for (int m = 0; m < 4; ++m) _Pragma("unroll") for (int k = 0; k < 2; ++k) dst[m][k] = *(const LAS bf16x8*)(lds + PG8_SA(b, h) + aoff + m * 2048 + k * 1024); } while (0)
#define PG8_LDB(dst, b, h) do { _Pragma("unroll") for (int n = 0; n < 2; ++n) _Pragma("unroll") for (int k = 0; k < 2; ++k) dst[n][k] = *(const LAS bf16x8*)(lds + PG8_SB(b, h) + boff + n * 2048 + k * 1024); } while (0)
#define PG8_MMA(ai, bj, At, Bt) do { __builtin_amdgcn_s_setprio(1); _Pragma("unroll") for (int m = 0; m < 4; ++m) _Pragma("unroll") for (int n = 0; n < 2; ++n) _Pragma("unroll") for (int k = 0; k < 2; ++k) \
        acc[ai][bj][m][n] = __builtin_amdgcn_mfma_f32_16x16x32_bf16(Bt[n][k], At[m][k], acc[ai][bj][m][n], 0, 0, 0); __builtin_amdgcn_s_setprio(0); } while (0)
#define PG8_WAIT_V(n) asm volatile("s_waitcnt vmcnt(" #n ")" ::: "memory")
#define PG8_WAIT_L(n) asm volatile("s_waitcnt lgkmcnt(" #n ")" ::: "memory")
#define PG8_BAR __builtin_amdgcn_s_barrier()
#define PG8_SCHED __builtin_amdgcn_sched_barrier(0)
    Unit cur, nxt; int ui = 0;
    if (!S.next(0, cur)) return;
    f32x4 acc[2][2][4][2];
#pragma unroll
    for (int a = 0; a < 2; ++a)
#pragma unroll
        for (int b = 0; b < 2; ++b)
#pragma unroll
            for (int m = 0; m < 4; ++m)
#pragma unroll
                for (int n = 0; n < 2; ++n) acc[a][b][m][n] = (f32x4){0.f, 0.f, 0.f, 0.f};
    bf16x8 At[4][2], B0[2][2], B1[2][2];
    const char* cA = (const char*)g.A + (size_t)cur.pm * tstep; const char* cB = (const char*)g.Bt + (size_t)cur.pn * tstep;
    PG8_STAGE(PG8_SB(0, 0), cB, voffB); PG8_STAGE(PG8_SA(0, 0), cA, voffA); PG8_STAGE(PG8_SB(0, 1), cB + hstep, voffB); PG8_STAGE(PG8_SA(0, 1), cA + hstep, voffA);
    if (wr == 1) PG8_BAR;
    PG8_WAIT_V(4); PG8_BAR;
    PG8_STAGE(PG8_SB(1, 0), cB + kstep, voffB); PG8_STAGE(PG8_SA(1, 0), cA + kstep, voffA); PG8_STAGE(PG8_SB(1, 1), cB + hstep + kstep, voffB);
    PG8_WAIT_V(6); PG8_BAR;
    for (;;) {
        const bool has_next = S.next(ui + 1, nxt);
        const char* nA = has_next ? (const char*)g.A + (size_t)nxt.pm * tstep : cA; const char* nB = has_next ? (const char*)g.Bt + (size_t)nxt.pn * tstep : cB;
        for (int t = 0; t < nt; t += 2) {
            const bool last = (t == nt - 2);
            const char* a1 = cA + (size_t)(t + 1) * kstep;
            const char* a2 = last ? nA : cA + (size_t)(t + 2) * kstep; const char* b2 = last ? nB : cB + (size_t)(t + 2) * kstep;
            const char* a3 = a2 + kstep; const char* b3 = b2 + kstep;
            PG8_LDB(B0, 0, 0); PG8_SCHED; PG8_LDA(At, 0, 0); PG8_STAGE(PG8_SA(1, 1), a1 + hstep, voffA);
            PG8_WAIT_L(8); PG8_BAR; PG8_WAIT_L(0); PG8_MMA(0, 0, At, B0); PG8_BAR; PG8_SCHED;
            PG8_LDB(B1, 0, 1); PG8_STAGE(PG8_SB(0, 0), b2, voffB);
            PG8_BAR; PG8_WAIT_L(0); PG8_MMA(0, 1, At, B1); PG8_BAR;
            PG8_LDA(At, 0, 1); PG8_STAGE(PG8_SA(0, 0), a2, voffA);
            PG8_BAR; PG8_WAIT_L(0); PG8_MMA(1, 0, At, B0); PG8_BAR; PG8_SCHED;
            PG8_STAGE(PG8_SB(0, 1), b2 + hstep, voffB);
            PG8_WAIT_V(6); PG8_BAR; PG8_MMA(1, 1, At, B1); PG8_BAR;
            PG8_LDB(B0, 1, 0); PG8_SCHED; PG8_LDA(At, 1, 0); PG8_STAGE(PG8_SA(0, 1), a2 + hstep, voffA);
            PG8_WAIT_L(8); PG8_BAR; PG8_WAIT_L(0); PG8_MMA(0, 0, At, B0); PG8_BAR; PG8_SCHED;
            PG8_LDB(B1, 1, 1); PG8_STAGE(PG8_SB(1, 0), b3, voffB);
            PG8_BAR; PG8_WAIT_L(0); PG8_MMA(0, 1, At, B1); PG8_BAR;
            PG8_LDA(At, 1, 1); PG8_STAGE(PG8_SA(1, 0), a3, voffA);
            PG8_BAR; PG8_WAIT_L(0); PG8_MMA(1, 0, At, B0); PG8_BAR; PG8_SCHED;
            PG8_STAGE(PG8_SB(1, 1), b3 + hstep, voffB);
            PG8_WAIT_V(6); PG8_BAR; PG8_MMA(1, 1, At, B1); PG8_BAR;
        }
        E(acc, cur, wr, wc, fr, fq);
        if (!has_next) break;
#pragma unroll
        for (int a = 0; a < 2; ++a)
#pragma unroll
            for (int b = 0; b < 2; ++b)
#pragma unroll
                for (int m = 0; m < 4; ++m)
#pragma unroll
                    for (int n = 0; n < 2; ++n) acc[a][b][m][n] = (f32x4){0.f, 0.f, 0.f, 0.f};
        cur = nxt; cA = nA; cB = nB; ++ui;
    }
    PG8_WAIT_V(0);
    if (wr == 0) PG8_BAR;
    PG8_BAR;
#undef PG8_SA
#undef PG8_SB
#undef PG8_STAGE
#undef PG8_LDA
#undef PG8_LDB
#undef PG8_MMA
#undef PG8_WAIT_V
#undef PG8_WAIT_L
#undef PG8_BAR
#undef PG8_SCHED
}
}

__device__ __forceinline__ void transpose_tile(const float* __restrict__ src, int ldsrc, int k0, int c0, bf16_t* __restrict__ dst, int lddst, int n0, float sc = 1.0f, const float* __restrict__ kscale = nullptr) {
    const int lane = threadIdx.x & 63;
    const float* p = src + (size_t)k0 * ldsrc + c0 + lane;
    float v[32];
#pragma unroll
    for (int k = 0; k < 32; ++k) v[k] = __builtin_nontemporal_load(p + (size_t)k * ldsrc);
    if (kscale) {
#pragma unroll
        for (int k = 0; k < 32; ++k) v[k] *= kscale[k0 + k];
    }
    bf16_t* q = dst + (size_t)(n0 + lane) * lddst + k0;
#pragma unroll
    for (int c = 0; c < 4; ++c) { u32x4 w; w.x = cvt_pk_bf16(v[8 * c] * sc, v[8 * c + 1] * sc); w.y = cvt_pk_bf16(v[8 * c + 2] * sc, v[8 * c + 3] * sc);
        w.z = cvt_pk_bf16(v[8 * c + 4] * sc, v[8 * c + 5] * sc); w.w = cvt_pk_bf16(v[8 * c + 6] * sc, v[8 * c + 7] * sc);
        *(u32x4*)(q + 8 * c) = w; }
}

__device__ __forceinline__ void phase_prep(const Args& a, unsigned char* shm) {
    bf16_t* WA = (bf16_t*)(a.ws + WS_WA); bf16_t* WV = (bf16_t*)(a.ws + WS_WV); bf16_t* WO = (bf16_t*)(a.ws + WS_WO);
    bf16_t* WGU = (bf16_t*)(a.ws + WS_WGU); bf16_t* WD = (bf16_t*)(a.ws + WS_WD);
    for (int ti = blockIdx.x * 8 + (threadIdx.x >> 6); ti < 6272; ti += gridDim.x * 8) {
        if (ti < 1024) { const int nt_ = ti >> 5, kt = ti & 31; const int n0 = nt_ * 64;
            const int c0 = n0 < 1024 ? n0 : (n0 < 1536 ? n0 + 512 : n0 + 1024);
            const float sc = n0 < 512 ? 0.125f * LOG2E : ((n0 >= 1280 && n0 < 1536) ? 0.125f : 1.0f);
            transpose_tile(a.w_in, 3072, kt * 32, c0, WA, 1024, n0, sc);
        } else if (ti < 1536) { const int q = ti - 1024, nt_ = q >> 5, kt = q & 31; const int n0 = nt_ * 64;
            const int c0 = n0 < 512 ? 1024 + n0 : n0 + 1536;
            transpose_tile(a.w_in, 3072, kt * 32, c0, WV, 1024, n0);
        } else if (ti < 2048) { const int q = ti - 1536, nt_ = q >> 5, kt = q & 31;
            transpose_tile(a.w_out, 1024, kt * 32, nt_ * 64, WO, 1024, nt_ * 64);
        } else if (ti < 4864) { const int q = ti - 2048, nt_ = q >> 5, kt = q & 31; const int n0 = nt_ * 64;
            const int P = n0 >> 8, bj = (n0 >> 7) & 1, j0 = n0 & 127;
            transpose_tile(bj ? a.w_up : a.w_gate, DFF, kt * 32, P * 128 + j0, WGU, 1024, n0, 1.0f, a.pre_ffn_g);
        } else { const int q = ti - 4864, nt_ = q / 88, kt = q % 88;
            transpose_tile(a.w_down, 1024, kt * 32, nt_ * 64, WD, DFF, nt_ * 64);
        }
    }
    { u32x4* z = (u32x4*)(a.ws + WS_STAT); const u32x4 zero = {0u, 0u, 0u, 0u};
      for (size_t i = (size_t)blockIdx.x * 512 + threadIdx.x; i < STAT_BYTES / 16; i += (size_t)gridDim.x * 512) z[i] = zero; }
    bf16_t* H = (bf16_t*)(a.ws + WS_H);
    const int wv = threadIdx.x >> 6, lane = threadIdx.x & 63;
    const f32x4 g0 = *(const f32x4*)(a.pre_mix_g + 8 * lane), g1 = *(const f32x4*)(a.pre_mix_g + 8 * lane + 4);
    const f32x4 g2 = *(const f32x4*)(a.pre_mix_g + 512 + 8 * lane), g3 = *(const f32x4*)(a.pre_mix_g + 512 + 8 * lane + 4);
    constexpr int R0 = 4;
    for (int rowb = (blockIdx.x * 8 + wv) * R0; rowb < MTOK; rowb += gridDim.x * 8 * R0) {
        f32x4 xv[R0][4];
#pragma unroll
        for (int rr = 0; rr < R0; ++rr) { const float* xr = a.x + (size_t)(rowb + rr) * DM;
            xv[rr][0] = __builtin_nontemporal_load((const f32x4*)(xr + 8 * lane)); xv[rr][1] = __builtin_nontemporal_load((const f32x4*)(xr + 8 * lane + 4));
            xv[rr][2] = __builtin_nontemporal_load((const f32x4*)(xr + 512 + 8 * lane)); xv[rr][3] = __builtin_nontemporal_load((const f32x4*)(xr + 512 + 8 * lane + 4)); }
#pragma unroll
        for (int rr = 0; rr < R0; ++rr) {
            const f32x4 x0 = xv[rr][0], x1 = xv[rr][1], x2 = xv[rr][2], x3 = xv[rr][3];
            float ss = 0.f;
#pragma unroll
            for (int j = 0; j < 4; ++j) ss += x0[j] * x0[j] + x1[j] * x1[j] + x2[j] * x2[j] + x3[j] * x3[j];
            ss = wave_sum(ss);
            const float rn = __frsqrt_rn(ss * (1.0f / DM) + EPS);
            u32x4 w0, w1;
            w0.x = cvt_pk_bf16(x0[0] * rn * g0[0], x0[1] * rn * g0[1]); w0.y = cvt_pk_bf16(x0[2] * rn * g0[2], x0[3] * rn * g0[3]);
            w0.z = cvt_pk_bf16(x1[0] * rn * g1[0], x1[1] * rn * g1[1]); w0.w = cvt_pk_bf16(x1[2] * rn * g1[2], x1[3] * rn * g1[3]);
            w1.x = cvt_pk_bf16(x2[0] * rn * g2[0], x2[1] * rn * g2[1]); w1.y = cvt_pk_bf16(x2[2] * rn * g2[2], x2[3] * rn * g2[3]);
            w1.z = cvt_pk_bf16(x3[0] * rn * g3[0], x3[1] * rn * g3[1]); w1.w = cvt_pk_bf16(x3[2] * rn * g3[2], x3[3] * rn * g3[3]);
            *(u32x4*)(H + (size_t)(rowb + rr) * DM + 8 * lane) = w0; *(u32x4*)(H + (size_t)(rowb + rr) * DM + 512 + 8 * lane) = w1;
        }
    }
}

__device__ __forceinline__ void unpack8(const u32x4 w, float (&v)[8]) {
    v[0] = bf_lo(w.x); v[1] = bf_hi(w.x); v[2] = bf_lo(w.y); v[3] = bf_hi(w.y); v[4] = bf_lo(w.z); v[5] = bf_hi(w.z); v[6] = bf_lo(w.w); v[7] = bf_hi(w.w);
}

constexpr int AT_STAGE = 49152;
constexpr int AT_VOFF = 16384;

template <int TYPE>
__device__ __forceinline__ void attn_unit(const Args& a, unsigned char* lds, int b, int hsel, int qblk, float lam) {
    int tid_ = threadIdx.x; asm volatile("" : "+v"(tid_));
    const int tid = tid_, wv = tid >> 6, lane = tid & 63, r = lane & 31, hh = lane >> 5;
    const int g = wv >> 2, wq = wv & 3;
    const bf16_t* QK = (const bf16_t*)(a.ws + WS_QK); const bf16_t* VT = (const bf16_t*)(a.ws + WS_VT); bf16_t* OMIX = (bf16_t*)(a.ws + WS_OMIX);
    const int tok0 = b * SEQ, q0 = TYPE == 0 ? qblk * 128 : qblk * 256 + g * 128;
    int qcol, vrow0;
    if (TYPE == 0) { qcol = hsel * 128 + g * 64; vrow0 = hsel * 128; }
    else { qcol = 1024 + hsel * 64; vrow0 = 512 + hsel * 128; }
    const int head = hsel;
    float c2;
    if (TYPE == 0) c2 = exp2f(-2.0f * (float)(head + 1)) * LOG2E;
    else c2 = log2f(1.0f - exp2f(-5.0f - (float)head));
    float c7[8], c4[4];
#pragma unroll
    for (int k = 0; k < 8; ++k) { const float v = TYPE == 0 ? c2 * (float)k : exp2f(-c2 * (float)k); c7[k] = __uint_as_float(__builtin_amdgcn_readfirstlane(__float_as_uint(v))); }
#pragma unroll
    for (int k = 0; k < 4; ++k) { const float v = TYPE == 0 ? c2 * (float)(16 * k) : exp2f(-c2 * (float)(16 * k)); c4[k] = __uint_as_float(__builtin_amdgcn_readfirstlane(__float_as_uint(v))); }
    const int qrow = q0 + wq * 32 + r;
    const float qposf = (float)qrow;
    bf16x8 qf[4];
    { const bf16_t* qp = QK + (size_t)(tok0 + qrow) * 2048 + qcol + hh * 8;
#pragma unroll
      for (int s = 0; s < 4; ++s) qf[s] = *(const bf16x8*)(qp + 16 * s); }
    f32x16 O[4];
#pragma unroll
    for (int d = 0; d < 4; ++d)
#pragma unroll
        for (int i = 0; i < 16; ++i) O[d][i] = 0.f;
    float m_run = -1e30f, l_run = 0.f;
    const int mychunk = TYPE == 0 ? 2 * qblk + (wq >> 1) : 4 * qblk + 2 * g + (wq >> 1), nsteps = TYPE == 0 ? 2 * (qblk + 1) : 4 * (qblk + 1);
    const int rs = (r & 0x13) | ((r & 4) << 1) | ((r & 8) >> 1);
    constexpr int KT = TYPE == 0 ? 8192 : 4096, VOFF = TYPE == 0 ? AT_VOFF : 8192;
    int kx[4], vx[4];
#pragma unroll
    for (int s = 0; s < 4; ++s) { kx[s] = TYPE == 0 ? rs * 256 + ((((g * 8 + hh) ^ (rs & 15)) ^ (2 * s)) << 4) : rs * 128 + ((((2 * s) + hh) ^ ((rs >> 1) & 7)) << 4);
        vx[s] = VOFF + r * 128 + (((hh ^ ((r >> 1) & 7)) ^ (2 * s)) << 4); }
    constexpr int NV = 2, NK = TYPE == 0 ? 2 : 1, NI = NK + NV;
    const int wvu = __builtin_amdgcn_readfirstlane(wv);
    const bf16_t* K2 = (const bf16_t*)(a.ws + WS_K2);
    const bf16_t* kt0 = K2 + ((size_t)(tok0 >> 6) * 6 + (TYPE == 0 ? hsel : 4 + (hsel >> 1))) * 8192 + (TYPE == 0 ? 0 : (hsel & 1) * 64);
    const bf16_t* vt0 = VT + ((size_t)(tok0 >> 6) * VT_ROWS + vrow0) * 64;
    unsigned kgo[NK], vgo[NV];
#pragma unroll
    for (int i = 0; i < NK; ++i) { if (TYPE == 0) { const int row = (wv * 2 + i) * 4 + (lane >> 4); kgo[i] = (unsigned)(row * 128 + (((lane & 15) ^ (row & 15)) << 3)) * 2u; }
        else { const int row = wv * 8 + (lane >> 3); kgo[i] = (unsigned)(row * 128 + (((lane & 7) ^ ((row >> 1) & 7)) << 3)) * 2u; } }
#pragma unroll
    for (int i = 0; i < NV; ++i) { const int row = (wv * NV + i) * 8 + (lane >> 3); vgo[i] = (unsigned)(row * 64 + (((lane & 7) ^ ((row >> 1) & 7)) << 3)) * 2u; }
    LAS unsigned char* ldsl = (LAS unsigned char*)lds;
#define AT_GLDS(j, stoff) do { const char* _kb = (const char*)(kt0 + (size_t)(j) * (6 * 8192)); const char* _vb = (const char*)(vt0 + (size_t)(j) * (VT_ROWS * 64)); \
        _Pragma("unroll") for (int _i = 0; _i < NK; ++_i) __builtin_amdgcn_global_load_lds((const unsigned*)(_kb + kgo[_i]), (LAS unsigned*)(ldsl + (stoff) + (wvu * NK + _i) * 1024), 16, 0, 0); \
        _Pragma("unroll") for (int _i = 0; _i < NV; ++_i) __builtin_amdgcn_global_load_lds((const unsigned*)(_vb + vgo[_i]), (LAS unsigned*)(ldsl + (stoff) + VOFF + (wvu * NV + _i) * 1024), 16, 0, 0); } while (0)
#pragma unroll
    for (int s = 0; s < 4; ++s) asm volatile("" : "+v"(qf[s]));
#define AT_PV(stp, PK) do { bf16x8 _av[16]; __builtin_amdgcn_s_setprio(1); \
        _Pragma("unroll") for (int t = 0; t < 2; ++t) _Pragma("unroll") for (int s2 = 0; s2 < 2; ++s2) _Pragma("unroll") for (int d = 0; d < 4; ++d) \
            _av[(2 * t + s2) * 4 + d] = *(const bf16x8*)((stp) + vx[2 * t + s2] + d * 4096); \
        _Pragma("unroll") for (int t = 0; t < 2; ++t) _Pragma("unroll") for (int s2 = 0; s2 < 2; ++s2) _Pragma("unroll") for (int d = 0; d < 4; ++d) \
            O[d] = __builtin_amdgcn_mfma_f32_32x32x16_bf16(_av[(2 * t + s2) * 4 + d], PK[t][s2], O[d], 0, 0, 0); \
        __builtin_amdgcn_sched_group_barrier(0x100, 4, 0); \
        _Pragma("unroll") for (int _q = 0; _q < 12; ++_q) { __builtin_amdgcn_sched_group_barrier(0x008, 1, 0); __builtin_amdgcn_sched_group_barrier(0x100, 1, 0); } \
        __builtin_amdgcn_sched_group_barrier(0x008, 4, 0); __builtin_amdgcn_s_setprio(0); } while (0)
    constexpr int NST = 4, STSZ = TYPE == 0 ? 32768 : 24576;
    const bool rot = g == 1;
    bf16x8 pk[2][2];
#pragma unroll
    for (int t = 0; t < 2; ++t)
#pragma unroll
        for (int s2 = 0; s2 < 2; ++s2) pk[t][s2] = (bf16x8){0, 0, 0, 0, 0, 0, 0, 0};
    bool live_c = false; const unsigned char* st_c = lds;
    AT_GLDS(nsteps - 1, 0); AT_GLDS(nsteps - 2, STSZ);
    int st_cur = 0, st_nx = 2 * STSZ;
    for (int jj = 0; jj < nsteps; ++jj) {
        const int j = nsteps - 1 - jj;
        if (jj + 1 < nsteps) { if (NI == 4) asm volatile("s_waitcnt vmcnt(4)" ::: "memory"); else asm volatile("s_waitcnt vmcnt(3)" ::: "memory"); }
        else asm volatile("s_waitcnt vmcnt(0)" ::: "memory");
        __builtin_amdgcn_s_barrier();
        asm volatile("" ::: "memory");
        if (jj + 2 < nsteps) AT_GLDS(j - 2, st_nx);
        const unsigned char* st = lds + st_cur;
        st_cur = st_cur == (NST - 1) * STSZ ? 0 : st_cur + STSZ; st_nx = st_nx == (NST - 1) * STSZ ? 0 : st_nx + STSZ;
        if (rot && live_c) AT_PV(st_c, pk);
        bool live = false;
        if (j <= mychunk) {
            f32x16 S0, S1;
#pragma unroll
            for (int i = 0; i < 16; ++i) { S0[i] = 0.f; S1[i] = 0.f; }
            { bf16x8 ka[8]; __builtin_amdgcn_s_setprio(1);
#pragma unroll
              for (int s = 0; s < 4; ++s) { ka[2 * s] = *(const bf16x8*)(st + kx[s]); ka[2 * s + 1] = *(const bf16x8*)(st + kx[s] + KT); }
#pragma unroll
              for (int s = 0; s < 4; ++s) { S0 = __builtin_amdgcn_mfma_f32_32x32x16_bf16(ka[2 * s], qf[s], S0, 0, 0, 0);
                  S1 = __builtin_amdgcn_mfma_f32_32x32x16_bf16(ka[2 * s + 1], qf[s], S1, 0, 0, 0); }
              __builtin_amdgcn_sched_group_barrier(0x100, 4, 0);
#pragma unroll
              for (int q_ = 0; q_ < 4; ++q_) { __builtin_amdgcn_sched_group_barrier(0x008, 1, 0); __builtin_amdgcn_sched_group_barrier(0x100, 1, 0); }
              __builtin_amdgcn_sched_group_barrier(0x008, 4, 0); __builtin_amdgcn_s_setprio(0); }
            MFMA_GUARD(S0, S1);
            const float d0 = (float)(64 * j + 8 * hh) - qposf;
            float gadd[4];
            live = true;
            if (TYPE == 0) {
                if (j == mychunk) {
#pragma unroll
                    for (int i = 0; i < 16; ++i) { const float off = (float)(16 * (i >> 3) + (i & 7));
                        S0[i] -= c2 * fabsf(d0 + off); S1[i] -= c2 * fabsf(d0 + off + 32.0f); }
#pragma unroll
                    for (int k = 0; k < 4; ++k) gadd[k] = 0.f;
                } else {
#pragma unroll
                    for (int i = 0; i < 16; ++i) { S0[i] = a_adds(c7[i & 7], S0[i]); S1[i] = a_adds(c7[i & 7], S1[i]); }
                    const float base = c2 * d0;
#pragma unroll
                    for (int k = 0; k < 4; ++k) gadd[k] = base + c4[k];
                }
                float m0 = a_max3(S0[0], S0[1], S0[2]), m1 = a_max3(S0[8], S0[9], S0[10]), m2 = a_max3(S1[0], S1[1], S1[2]), m3 = a_max3(S1[8], S1[9], S1[10]);
                m0 = a_max3(m0, S0[3], S0[4]); m1 = a_max3(m1, S0[11], S0[12]); m2 = a_max3(m2, S1[3], S1[4]); m3 = a_max3(m3, S1[11], S1[12]);
                m0 = a_max3(m0, S0[5], S0[6]); m1 = a_max3(m1, S0[13], S0[14]); m2 = a_max3(m2, S1[5], S1[6]); m3 = a_max3(m3, S1[13], S1[14]);
                m0 = a_max(m0, S0[7]); m1 = a_max(m1, S0[15]); m2 = a_max(m2, S1[7]); m3 = a_max(m3, S1[15]);
                float mx = a_max3(a_add(m0, gadd[0]), a_add(m1, gadd[1]), a_max(a_add(m2, gadd[2]), a_add(m3, gadd[3])));
                mx = half_max(mx);
                if (__all(mx < m_run - 40.0f)) live = false;
                else {
                    if (!__all(mx <= m_run + 8.0f)) {
                        const float mn = fmaxf(m_run, mx); const float alpha = __builtin_amdgcn_exp2f(m_run - mn); m_run = mn; l_run *= alpha;
#pragma unroll
                        for (int d = 0; d < 4; ++d)
#pragma unroll
                            for (int i = 0; i < 16; ++i) O[d][i] *= alpha;
                    }
                    const float g0 = gadd[0] - m_run, g1 = gadd[1] - m_run, g2 = gadd[2] - m_run, g3 = gadd[3] - m_run;
                    float pa = 0.f, pb = 0.f, pc = 0.f, pd = 0.f;
#pragma unroll
                    for (int i = 0; i < 8; ++i) { S0[i] = __builtin_amdgcn_exp2f(a_add(S0[i], g0)); S0[8 + i] = __builtin_amdgcn_exp2f(a_add(S0[8 + i], g1));
                        S1[i] = __builtin_amdgcn_exp2f(a_add(S1[i], g2)); S1[8 + i] = __builtin_amdgcn_exp2f(a_add(S1[8 + i], g3));
                        pa = a_add(pa, S0[i]); pb = a_add(pb, S0[8 + i]); pc = a_add(pc, S1[i]); pd = a_add(pd, S1[8 + i]); }
                    l_run += a_add(a_add(pa, pb), a_add(pc, pd));
                }
            } else {
                if (j == mychunk) {
#pragma unroll
                    for (int i = 0; i < 16; ++i) { const float off = (float)(16 * (i >> 3) + (i & 7));
                        S0[i] *= __builtin_amdgcn_exp2f(c2 * fabsf(d0 + off)); S1[i] *= __builtin_amdgcn_exp2f(c2 * fabsf(d0 + off + 32.0f)); }
                } else {
                    const float fl = __builtin_amdgcn_exp2f(-c2 * d0);
                    const float g0 = fl * c4[0], g1 = fl * c4[1], g2 = fl * c4[2], g3 = fl * c4[3];
#pragma unroll
                    for (int i = 0; i < 8; ++i) { S0[i] = a_mul(a_muls(c7[i], S0[i]), g0); S0[8 + i] = a_mul(a_muls(c7[i], S0[8 + i]), g1); S1[i] = a_mul(a_muls(c7[i], S1[i]), g2); S1[8 + i] = a_mul(a_muls(c7[i], S1[8 + i]), g3); }
                }
            }
            if (live) {
#pragma unroll
                for (int s2 = 0; s2 < 2; ++s2) {
                    u32x4 w0, w1;
                    w0.x = cvt_pk_bf16(S0[8 * s2], S0[8 * s2 + 1]); w0.y = cvt_pk_bf16(S0[8 * s2 + 2], S0[8 * s2 + 3]); w0.z = cvt_pk_bf16(S0[8 * s2 + 4], S0[8 * s2 + 5]); w0.w = cvt_pk_bf16(S0[8 * s2 + 6], S0[8 * s2 + 7]);
                    w1.x = cvt_pk_bf16(S1[8 * s2], S1[8 * s2 + 1]); w1.y = cvt_pk_bf16(S1[8 * s2 + 2], S1[8 * s2 + 3]); w1.z = cvt_pk_bf16(S1[8 * s2 + 4], S1[8 * s2 + 5]); w1.w = cvt_pk_bf16(S1[8 * s2 + 6], S1[8 * s2 + 7]);
                    pk[0][s2] = *reinterpret_cast<bf16x8*>(&w0); pk[1][s2] = *reinterpret_cast<bf16x8*>(&w1);
                }
                if (!rot) AT_PV(st, pk);
            }
        }
        live_c = live; st_c = st;
    }
    if (rot && live_c) AT_PV(st_c, pk);
    __syncthreads();
#undef AT_GLDS
#undef AT_PV
    const size_t tokb = (size_t)(tok0 + q0 + wq * 32);
    constexpr int TPITCH = 272;
    if (TYPE == 0) {
        const float lt = half_sum(l_run);
        float* comb = (float*)lds;
        if (g == 1) { const float sc = lam / lt;
#pragma unroll
            for (int d = 0; d < 4; ++d)
#pragma unroll
                for (int i = 0; i < 16; ++i) comb[(wq * 64 + d * 16 + i) * 64 + lane] = O[d][i] * sc; }
        __syncthreads();
        if (g == 0) { const float inv = 1.0f / lt; float ss = 0.f;
#pragma unroll
            for (int d = 0; d < 4; ++d)
#pragma unroll
                for (int i = 0; i < 16; ++i) { const float v = O[d][i] * inv - comb[(wq * 64 + d * 16 + i) * 64 + lane]; O[d][i] = v; ss += v * v; }
            ss = half_sum(ss);
            const float rn = __frsqrt_rn(ss * (1.0f / 128.0f) + EPS) * 0.8f;
            unsigned char* tile = lds + 65536 + wq * (32 * TPITCH);
#pragma unroll
            for (int d = 0; d < 4; ++d)
#pragma unroll
                for (int q4 = 0; q4 < 4; ++q4) { const int dv = 32 * d + 8 * q4 + 4 * hh;
                    const f32x4 gv = *(const f32x4*)(a.subln_g + dv);
                    u32x2 w; w.x = cvt_pk_bf16(O[d][4 * q4] * rn * gv[0], O[d][4 * q4 + 1] * rn * gv[1]); w.y = cvt_pk_bf16(O[d][4 * q4 + 2] * rn * gv[2], O[d][4 * q4 + 3] * rn * gv[3]);
                    *(u32x2*)(tile + r * TPITCH + dv * 2) = w; }
            bf16_t* op = OMIX + tokb * DM + hsel * 128 + (lane & 15) * 8;
#pragma unroll
            for (int k = 0; k < 8; ++k) { const int row = 4 * k + (lane >> 4);
                const u32x4 v = *(const u32x4*)(tile + row * TPITCH + (lane & 15) * 16);
                *(u32x4*)(op + (size_t)row * DM) = v; } }
        __syncthreads();
    } else {
        float ss = 0.f;
#pragma unroll
        for (int d = 0; d < 4; ++d)
#pragma unroll
            for (int i = 0; i < 16; ++i) ss += O[d][i] * O[d][i];
        ss = half_sum(ss);
        const float rn = __frsqrt_rn(ss * (1.0f / 128.0f) + EPS);
        unsigned char* tile = lds + 49152 + wv * (32 * TPITCH);
#pragma unroll
        for (int d = 0; d < 4; ++d)
#pragma unroll
            for (int q4 = 0; q4 < 4; ++q4) { const int dv = 32 * d + 8 * q4 + 4 * hh;
                const f32x4 gv = *(const f32x4*)(a.ret_g + dv);
                u32x2 w; w.x = cvt_pk_bf16(O[d][4 * q4] * rn * gv[0], O[d][4 * q4 + 1] * rn * gv[1]); w.y = cvt_pk_bf16(O[d][4 * q4 + 2] * rn * gv[2], O[d][4 * q4 + 3] * rn * gv[3]);
                *(u32x2*)(tile + r * TPITCH + dv * 2) = w; }
        const bf16_t* gp = QK + tokb * 2048 + 1536 + head * 128 + (lane & 15) * 8;
        bf16_t* op = OMIX + tokb * DM + 512 + head * 128 + (lane & 15) * 8;
        u32x4 gw[8];
#pragma unroll
        for (int k = 0; k < 8; ++k) gw[k] = *(const u32x4*)(gp + (size_t)(4 * k + (lane >> 4)) * 2048);
#pragma unroll
        for (int k = 0; k < 8; ++k) { const int row = 4 * k + (lane >> 4);
            const u32x4 v = *(const u32x4*)(tile + row * TPITCH + (lane & 15) * 16);
            float vv[8], gg[8]; unpack8(v, vv); unpack8(gw[k], gg);
#pragma unroll
            for (int e = 0; e < 8; ++e) vv[e] *= gg[e] * __builtin_amdgcn_rcpf(1.0f + __builtin_amdgcn_exp2f(-gg[e] * LOG2E));
            u32x4 w; w.x = cvt_pk_bf16(vv[0], vv[1]); w.y = cvt_pk_bf16(vv[2], vv[3]); w.z = cvt_pk_bf16(vv[4], vv[5]); w.w = cvt_pk_bf16(vv[6], vv[7]);
            *(u32x4*)(op + (size_t)row * DM) = w; }
        __syncthreads();
    }
}

__device__ __forceinline__ void phase_mixer(const Args& a, unsigned char* lds, int segmask = 7) {
    unsigned* barw = (unsigned*)(a.ws + WS_BAR);
    bool xcc_ok = gridDim.x == 256;
    for (int j = 0; j < 16; ++j) { const unsigned c = xb_ld(&barw[XB_XCNT(j)]); xcc_ok = xcc_ok && (c == (j < 8 ? 32u : 0u)); }
    const unsigned my_rank = ((volatile LAS unsigned*)((LAS unsigned char*)lds + 3 * AT_STAGE))[2];
    const int slot_xcc = (int)(xb_xcc_id() * 32u + my_rank);

    const int lane = threadIdx.x & 63;
    const float d1 = wave_sum(a.lq1[lane] * a.lk1[lane]), d2 = wave_sum(a.lq2[lane] * a.lk2[lane]);
    const float lam = expf(d1) - expf(d2) + 0.2f;
    for (int i = blockIdx.x; i < 768; i += gridDim.x) {
        const int seg = i >> 8, w = i & 255, p = xcc_ok ? slot_xcc : (w & 7) * 32 + (w >> 3);
        if (!((segmask >> seg) & 1)) continue;
        if (seg < 2) { const int pp = seg * 256 + p, bh = pp >> 3, pi = pp & 7; const int hd = seg ? 3 - (bh & 3) : (bh & 3);
            attn_unit<0>(a, lds, bh >> 2, hd, pi, lam); attn_unit<0>(a, lds, bh >> 2, hd, 15 - pi, lam);
        } else { const int b = p >> 4, hd = (p >> 2) & 3, pi = p & 3;
            attn_unit<1>(a, lds, b, hd, pi, lam); attn_unit<1>(a, lds, b, hd, 7 - pi, lam); }
    }
}

__global__ void __launch_bounds__(512, 2) fwd_mega(Args a, int ph_lo, int ph_hi) {
    extern __shared__ __attribute__((aligned(16))) unsigned char shm[];
    cg::grid_group grid = cg::this_grid();
    bf16_t* WA = (bf16_t*)(a.ws + WS_WA); bf16_t* WV = (bf16_t*)(a.ws + WS_WV); bf16_t* WO = (bf16_t*)(a.ws + WS_WO);
    bf16_t* WGU = (bf16_t*)(a.ws + WS_WGU); bf16_t* WD = (bf16_t*)(a.ws + WS_WD); bf16_t* H = (bf16_t*)(a.ws + WS_H);
    bf16_t* QK = (bf16_t*)(a.ws + WS_QK); bf16_t* VT = (bf16_t*)(a.ws + WS_VT); bf16_t* OMIX = (bf16_t*)(a.ws + WS_OMIX);
    bf16_t* MIXB = (bf16_t*)(a.ws + WS_MIXB); bf16_t* F = (bf16_t*)(a.ws + WS_F);
    LAS unsigned char* lds = (LAS unsigned char*)shm;
    volatile LAS unsigned* xbw = (volatile LAS unsigned*)(lds + 3 * AT_STAGE);
    if (threadIdx.x == 0) { xbw[0] = 0u; xbw[1] = 0u; xbw[2] = 0u; xbw[3] = 0u; }
    __syncthreads();
    const XcdBarrier xb = xcd_barrier_post((unsigned*)(a.ws + WS_BAR), xbw);
    if (threadIdx.x == 0) xbw[2] = xb_add(&xb.bar[XB_TKT(xb.x)], 1u);
    if (ph_hi > 1000) grid.sync();
#ifndef PHMASK
#define PHMASK 255
#endif
#ifndef DUP
#define DUP 0
#endif
#define PH_ON(k) (ph_lo <= (k) && (k) < ph_hi)
#define PH_SYNC(k) do { if (ph_lo < (k) && (k) < ph_hi) xcd_barrier(xb); } while (0)
    if ((PHMASK & 1) && PH_ON(0)) phase_prep(a, shm);
    if (DUP & 1) { xcd_barrier(xb); phase_prep(a, shm); }
    PH_SYNC(1);
    if ((PHMASK & 2) && PH_ON(1)) {
        { pg8::StaticOrder S; S.init(MTOK, 2048, (int)gridDim.x, (int)blockIdx.x);
          pg8::gemm_phase(lds, pg8::Gemm{H, WA, MTOK, 2048, DM}, S, pg8::EpiQK{QK, (bf16_t*)(a.ws + WS_K2)}); }
        { pg8::StaticOrder S2; S2.init(1024, MTOK, (int)gridDim.x, (int)blockIdx.x);
          pg8::gemm_phase(lds, pg8::Gemm{WV, H, 1024, MTOK, DM}, S2, pg8::EpiVT{VT}); }
    }
    if (DUP & 2) { xcd_barrier(xb);
        { pg8::StaticOrder S; S.init(MTOK, 2048, (int)gridDim.x, (int)blockIdx.x);
          pg8::gemm_phase(lds, pg8::Gemm{H, WA, MTOK, 2048, DM}, S, pg8::EpiQK{QK, (bf16_t*)(a.ws + WS_K2)}); }
        { pg8::StaticOrder S2; S2.init(1024, MTOK, (int)gridDim.x, (int)blockIdx.x);
          pg8::gemm_phase(lds, pg8::Gemm{WV, H, 1024, MTOK, DM}, S2, pg8::EpiVT{VT}); } }
    PH_SYNC(2);
    if ((PHMASK & 4) && PH_ON(2)) phase_mixer(a, shm);
    if (DUP & 4) { xcd_barrier(xb); phase_mixer(a, shm); }
    if (DUP & 256) { xcd_barrier(xb); phase_mixer(a, shm, 3); }
    if (DUP & 512) { xcd_barrier(xb); phase_mixer(a, shm, 4); }
    PH_SYNC(3);
    if ((PHMASK & 8) && PH_ON(3)) {
        pg8::StaticOrder S; S.init(MTOK, DM, (int)gridDim.x, (int)blockIdx.x);
        unsigned long long* ss = (unsigned long long*)(a.ws + WS_STAT); unsigned* cn = (unsigned*)(a.ws + WS_STAT + STAT_CNT_OFF);
        pg8::gemm_phase(lds, pg8::Gemm{OMIX, WO, MTOK, DM, DM}, S, pg8::EpiNormResNorm{a.x, MIXB, a.post_mix_g, ss, ss + MTOK, cn});
    }
    PH_SYNC(5);
    if ((PHMASK & 32) && PH_ON(5)) {
        pg8::StaticOrder S; S.init(MTOK, 2 * DFF, (int)gridDim.x, (int)blockIdx.x);
        pg8::gemm_phase(lds, pg8::Gemm{MIXB, WGU, MTOK, 2 * DFF, DM}, S, pg8::EpiSwiGLU{F, DFF, (unsigned long long*)(a.ws + WS_STAT) + MTOK});
    }
    if (DUP & 32) { xcd_barrier(xb);
        pg8::StaticOrder S; S.init(MTOK, 2 * DFF, (int)gridDim.x, (int)blockIdx.x);
        pg8::gemm_phase(lds, pg8::Gemm{MIXB, WGU, MTOK, 2 * DFF, DM}, S, pg8::EpiSwiGLU{F, DFF, (unsigned long long*)(a.ws + WS_STAT) + MTOK}); }
    PH_SYNC(6);
    if ((PHMASK & 64) && PH_ON(6)) {
        pg8::StaticOrder S; S.init(MTOK, DM, (int)gridDim.x, (int)blockIdx.x);
        pg8::gemm_phase(lds, pg8::Gemm{F, WD, MTOK, DM, DFF}, S, pg8::EpiNormRes{a.out, MIXB, a.post_ffn_g, (unsigned long long*)(a.ws + WS_STAT) + 2 * (size_t)MTOK, (unsigned*)(a.ws + WS_STAT + STAT_CNT_OFF) + 2 * 256 * 64});
    }
}

constexpr int LDS_BYTES = 3 * AT_STAGE + 16;

extern "C" void kernel_launch(void* const* d_in, const int* in_sizes, int n_in, void* d_out, int out_size, void* d_ws, size_t ws_size, hipStream_t stream) {
    static int grid_blocks = 0;
    if (!grid_blocks) {
        int dev = 0, cus = 0, per_cu = 0;
        hipGetDevice(&dev);
        hipDeviceGetAttribute(&cus, hipDeviceAttributeMultiprocessorCount, dev);
        if (hipFuncSetAttribute((const void*)fwd_mega, hipFuncAttributeMaxDynamicSharedMemorySize, LDS_BYTES) != hipSuccess) fprintf(stderr, "hipFuncSetAttribute failed\n");
        if (hipOccupancyMaxActiveBlocksPerMultiprocessor(&per_cu, (const void*)fwd_mega, 512, LDS_BYTES) != hipSuccess || per_cu < 1) { fprintf(stderr, "occupancy query: %d\n", per_cu); per_cu = 1; }
        (void)hipGetLastError();
        grid_blocks = cus * 1;
        if (ws_size < WS_END) fprintf(stderr, "workspace too small: %zu < %zu\n", ws_size, (size_t)WS_END);
    }
    if (hipMemsetAsync((char*)d_ws + WS_BAR, 0, 32768, stream) != hipSuccess) fprintf(stderr, "memset of the barrier words failed\n");
    Args a{};
    a.x = (const float*)d_in[0]; a.pre_mix_g = (const float*)d_in[1]; a.w_in = (const float*)d_in[2];
    a.lq1 = (const float*)d_in[3]; a.lk1 = (const float*)d_in[4]; a.lq2 = (const float*)d_in[5]; a.lk2 = (const float*)d_in[6];
    a.subln_g = (const float*)d_in[7]; a.ret_g = (const float*)d_in[8]; a.w_out = (const float*)d_in[9];
    a.post_mix_g = (const float*)d_in[10]; a.pre_ffn_g = (const float*)d_in[11];
    a.w_gate = (const float*)d_in[12]; a.w_up = (const float*)d_in[13]; a.w_down = (const float*)d_in[14]; a.post_ffn_g = (const float*)d_in[15];
    a.out = (float*)d_out; a.ws = (unsigned char*)d_ws;
    int ph_lo = 0, ph_hi = 8;
    void* args[] = {&a, &ph_lo, &ph_hi};
    hipError_t e = hipLaunchCooperativeKernel((const void*)fwd_mega, dim3(grid_blocks), dim3(512), args, LDS_BYTES, stream);
    if (e != hipSuccess) fprintf(stderr, "cooperative launch failed: %s (grid %d)\n", hipGetErrorString(e), grid_blocks);
}
```
